# Optimizing an MI355X kernel written in HIP

```python
import math
import jax, jax.numpy as jnp
from jax import lax
import numpy as np

D_MODEL = 1024
BATCH = 16
SEQ = 2048
DEPTH = 4

CHUNK = 64
Q_BLOCK = 128
HEAD_DIM = 64
H_SB = 8
H_DIFF = 4
H_CH = 8
N_PAST_CHUNKS = 8
BAND = (N_PAST_CHUNKS + 1) * CHUNK
REL_CLIP = 128
W_SB = H_SB * HEAD_DIM
W_DIFF = H_DIFF * 2 * HEAD_DIM
W_CH = H_CH * HEAD_DIM
N_BRANCH = 3
D_FF = int(math.ceil(8 * D_MODEL / 3 / 256)) * 256
RMS_EPS = 1e-6
_SIZES = (W_SB, W_SB, W_SB, W_DIFF, W_DIFF, W_DIFF, W_CH, W_CH, W_CH, N_BRANCH * D_MODEL)
N_IN = int(sum(_SIZES))
_SPLIT_POINTS = tuple(int(v) for v in np.cumsum(_SIZES)[:-1])

kernel_name = "hybrid_stickbreak_diff_chunkrel_gated"


def alibi_slopes(n):
    return np.asarray([2.0 ** (-8.0 * (i + 1) / n) for i in range(n)], dtype=np.float32)


def rms_norm(x, g):
    xf = x.astype(jnp.float32)
    y = xf * lax.rsqrt(jnp.mean(xf * xf, axis=-1, keepdims=True) + RMS_EPS)
    return (y * g.astype(jnp.float32)).astype(x.dtype)


def to_heads(t, n_heads):
    b, s, _ = t.shape
    return t.reshape(b, s, n_heads, -1).transpose(0, 2, 1, 3)


def merge_heads(t):
    b, h, s, d = t.shape
    return t.transpose(0, 2, 1, 3).reshape(b, s, h * d)


def stick_breaking_attention(q, k, v):
    b, h, s, d = q.shape
    nqb = s // Q_BLOCK
    scale = d ** -0.5
    kpos = jnp.arange(s)
    qb = q.reshape(b, h, nqb, Q_BLOCK, d).transpose(2, 0, 1, 3, 4)

    def block(args):
        q_blk, i = args
        qpos = i * Q_BLOCK + jnp.arange(Q_BLOCK)
        z = jnp.einsum('bhqd,bhkd->bhqk', q_blk, k, preferred_element_type=jnp.float32) * scale
        strict = kpos[None, :] < qpos[:, None]
        log_beta = jax.nn.log_sigmoid(z)
        log_1m = jnp.where(strict, jax.nn.log_sigmoid(-z), 0.0)
        after = lax.cumsum(log_1m, axis=3, reverse=True) - log_1m
        w = jnp.where(strict, jnp.exp(log_beta + after), 0.0)
        return jnp.einsum('bhqk,bhkd->bhqd', w.astype(v.dtype), v)

    out = lax.map(block, (qb, jnp.arange(nqb)))
    return out.transpose(1, 2, 0, 3, 4).reshape(b, h, s, d)


def diff_attention(q, k, v, lam, slopes):
    b, h, _, s, d = q.shape
    nqb = s // Q_BLOCK
    scale = d ** -0.5
    kpos = jnp.arange(s)
    qb = q.reshape(b, h, 2, nqb, Q_BLOCK, d).transpose(3, 0, 1, 2, 4, 5)

    def block(args):
        q_blk, i = args
        qpos = i * Q_BLOCK + jnp.arange(Q_BLOCK)
        allowed = (kpos[None, :] // CHUNK) <= (qpos[:, None] // CHUNK)
        dist = jnp.abs(qpos[:, None] - kpos[None, :]).astype(jnp.float32)
        bias = -slopes[:, None, None] * dist[None]
        logits = jnp.einsum('bhmqd,bhmkd->bhmqk', q_blk, k, preferred_element_type=jnp.float32) * scale
        logits = jnp.where(allowed[None, None, None], logits + bias[None, :, None], -jnp.inf)
        p = jax.nn.softmax(logits, axis=-1)
        w = p[:, :, 0] - lam * p[:, :, 1]
        return jnp.einsum('bhqk,bhkd->bhqd', w.astype(v.dtype), v)

    out = lax.map(block, (qb, jnp.arange(nqb)))
    return out.transpose(1, 2, 0, 3, 4).reshape(b, h, s, 2 * d)


def chunked_rel_attention(q, k, v, rel_bias):
    b, h, s, d = q.shape
    nc = s // CHUNK
    pad = N_PAST_CHUNKS * CHUNK
    scale = d ** -0.5
    kp = jnp.pad(k, ((0, 0), (0, 0), (pad, 0), (0, 0)))
    vp = jnp.pad(v, ((0, 0), (0, 0), (pad, 0), (0, 0)))
    qc = q.reshape(b, h, nc, CHUNK, d).transpose(2, 0, 1, 3, 4)
    koff = jnp.arange(BAND)
    rel = (pad + jnp.arange(CHUNK))[:, None] - koff[None, :]
    bias = rel_bias[:, jnp.clip(rel, -REL_CLIP, REL_CLIP) + REL_CLIP].astype(jnp.float32)

    def one_chunk(args):
        q_c, c = args
        start = c * CHUNK
        k_band = lax.dynamic_slice_in_dim(kp, start, BAND, axis=2)
        v_band = lax.dynamic_slice_in_dim(vp, start, BAND, axis=2)
        valid = (start + koff) >= pad
        logits = jnp.einsum('bhqd,bhkd->bhqk', q_c, k_band, preferred_element_type=jnp.float32) * scale
        logits = jnp.where(valid[None, None, None, :], logits + bias[None], -jnp.inf)
        p = jax.nn.softmax(logits, axis=-1)
        return jnp.einsum('bhqk,bhkd->bhqd', p.astype(v_band.dtype), v_band)

    out = lax.map(one_chunk, (qc, jnp.arange(nc)))
    return out.transpose(1, 2, 0, 3, 4).reshape(b, h, s, d)


def setup_inputs(seed: int = 0) -> dict:
    key = jax.random.key(seed)
    ks = jax.random.split(key, 17)
    n = jax.random.normal
    f32 = jnp.float32
    return {
        "x": n(ks[0], (BATCH, SEQ, D_MODEL), f32),
        "norm_mix_g": 1.0 + 0.02 * n(ks[1], (DEPTH, D_MODEL), f32),
        "w_in": n(ks[2], (DEPTH, D_MODEL, N_IN), f32) * D_MODEL ** -0.5,
        "b_gate": 0.1 * n(ks[3], (DEPTH, N_BRANCH, D_MODEL), f32),
        "qk_g_diff": 1.0 + 0.02 * n(ks[4], (DEPTH, 2, HEAD_DIM), f32),
        "lambda_qk": 0.1 * n(ks[5], (DEPTH, 4, HEAD_DIM), f32),
        "subln_g": 1.0 + 0.02 * n(ks[6], (DEPTH, 2 * HEAD_DIM), f32),
        "qk_g_ch": 1.0 + 0.02 * n(ks[7], (DEPTH, 2, HEAD_DIM), f32),
        "rel_bias": 0.1 * n(ks[8], (DEPTH, H_CH, 2 * REL_CLIP + 1), f32),
        "w_branch_sb": n(ks[9], (DEPTH, W_SB, D_MODEL), f32) * W_SB ** -0.5,
        "w_branch_diff": n(ks[10], (DEPTH, W_DIFF, D_MODEL), f32) * W_DIFF ** -0.5,
        "w_branch_ch": n(ks[11], (DEPTH, W_CH, D_MODEL), f32) * W_CH ** -0.5,
        "w_out": n(ks[12], (DEPTH, D_MODEL, D_MODEL), f32) * D_MODEL ** -0.5,
        "norm_ffn_g": 1.0 + 0.02 * n(ks[13], (DEPTH, D_MODEL), f32),
        "w_gu": n(ks[14], (DEPTH, D_MODEL, 2 * D_FF), f32) * D_MODEL ** -0.5,
        "w_down": n(ks[15], (DEPTH, D_FF, D_MODEL), f32) * D_FF ** -0.5,
    }


def reference(x, norm_mix_g, w_in, b_gate, qk_g_diff, lambda_qk, subln_g, qk_g_ch, rel_bias,
              w_branch_sb, w_branch_diff, w_branch_ch, w_out, norm_ffn_g, w_gu, w_down):
    b, s, _ = x.shape
    slopes = jnp.asarray(alibi_slopes(H_DIFF))
    for l in range(DEPTH):
        h = rms_norm(x, norm_mix_g[l])
        proj = h @ w_in[l]
        (q_a, k_a, v_a, q_b, k_b, v_b, q_c, k_c, v_c, g_lin) = jnp.split(proj, _SPLIT_POINTS, axis=-1)

        o_a = merge_heads(stick_breaking_attention(to_heads(q_a, H_SB), to_heads(k_a, H_SB), to_heads(v_a, H_SB)))

        qb = rms_norm(q_b.reshape(b, s, H_DIFF, 2, HEAD_DIM).transpose(0, 2, 3, 1, 4), qk_g_diff[l, 0])
        kb = rms_norm(k_b.reshape(b, s, H_DIFF, 2, HEAD_DIM).transpose(0, 2, 3, 1, 4), qk_g_diff[l, 1])
        vb = to_heads(v_b, H_DIFF)
        lam_init = 0.8 - 0.6 * math.exp(-0.3 * l)
        lq = lambda_qk[l].astype(jnp.float32)
        lam = jnp.exp(jnp.sum(lq[0] * lq[1])) - jnp.exp(jnp.sum(lq[2] * lq[3])) + lam_init
        ob = diff_attention(qb, kb, vb, lam, slopes)
        o_b = merge_heads(rms_norm(ob, subln_g[l]) * (1.0 - lam_init))

        qc = rms_norm(to_heads(q_c, H_CH), qk_g_ch[l, 0])
        kc = rms_norm(to_heads(k_c, H_CH), qk_g_ch[l, 1])
        o_c = merge_heads(chunked_rel_attention(qc, kc, to_heads(v_c, H_CH), rel_bias[l]))

        gates = jax.nn.sigmoid(g_lin.reshape(b, s, N_BRANCH, D_MODEL) + b_gate[l])
        merged = (gates[:, :, 0] * (o_a @ w_branch_sb[l])
                  + gates[:, :, 1] * (o_b @ w_branch_diff[l])
                  + gates[:, :, 2] * (o_c @ w_branch_ch[l]))
        x = x + merged @ w_out[l]

        h2 = rms_norm(x, norm_ffn_g[l])
        gate, up = jnp.split(h2 @ w_gu[l], 2, axis=-1)
        x = x + (jax.nn.silu(gate) * up) @ w_down[l]
    return x
```

```cpp
#include <hip/hip_runtime.h>
#include <hip/hip_cooperative_groups.h>
#include <cstdio>
#include <cstdint>
namespace cg = cooperative_groups;
#define GAS __attribute__((address_space(1)))
namespace pg8 {
#define PG8_LAS __attribute__((address_space(3)))
typedef unsigned short bf16_t;
typedef short bf16x8 __attribute__((ext_vector_type(8)));
typedef float f32x4 __attribute__((ext_vector_type(4)));
typedef unsigned u32x4 __attribute__((ext_vector_type(4)));
constexpr int BM = 256, BK = 64, HALF = 128, HTB = HALF * BK * 2  , STAGE_BYTES = 8 * HTB, NXCD = 8, WGM = 4;

__host__ __device__ __forceinline__ int lds_byte(int r, int c) { const int st = (r >> 4) * 2 + (c >> 5), rr = r & 15, cc = c & 31, ob = rr * 64 + cc * 2; return st * 1024 + (ob ^ (((ob >> 9) & 1) << 5)); }
__host__ __device__ __forceinline__ void stage_rc(int b, int& R, int& C) { const int st = b / 1024, sb = b % 1024, swz = sb ^ (((sb >> 9) & 1) << 5); R = (st >> 1) * 16 + swz / 64; C = (st & 1) * 32 + (swz % 64) / 2; }
__host__ __device__ __forceinline__ int perm32(int rho) { const int n = rho >> 4, i = rho & 15; return 8 * (i >> 2) + 4 * n + (i & 3); }

struct Unit { int pm, pn; };
struct Gemm { const __attribute__((address_space(1))) bf16_t* A; const __attribute__((address_space(1))) bf16_t* Bt; int M, N, K; };

struct StaticOrder {
    int nM, nN, nwg, G, c;
    __host__ __device__ void init(int M, int N, int G_, int c_) { nM = M / BM; nN = N / BM; nwg = nM * nN; G = G_; c = c_; }
    __host__ __device__ bool next(int i, Unit& u) const {
        const long L = (long)i * G + c; if (L >= nwg) return false;
        int wgid = (int)L; { const int q = nwg / NXCD, r = nwg % NXCD, xcd = wgid % NXCD, off = wgid / NXCD; wgid = (xcd < r ? xcd * (q + 1) : r * (q + 1) + (xcd - r) * q) + off; }
        const int nig = WGM * nN, gid = wgid / nig, fm = gid * WGM, gsz = (nM - fm) < WGM ? (nM - fm) : WGM;
        u.pm = fm + ((wgid % nig) % gsz); u.pn = (wgid % nig) / gsz; return true;
    }
    __device__ __forceinline__ void a_ready(const Unit&) const {}
    __device__ __forceinline__ void done(const Unit&) const {}
};

typedef float f32x2 __attribute__((ext_vector_type(2)));
typedef __bf16 bf16x2_t __attribute__((ext_vector_type(2)));
typedef unsigned u32x2 __attribute__((ext_vector_type(2)));
__device__ __forceinline__ unsigned cvt_pk_bf16(float lo, float hi) { f32x2 v = {lo, hi}; bf16x2_t b = __builtin_convertvector(v, bf16x2_t); return __builtin_bit_cast(unsigned, b); }
__device__ __forceinline__ float bf_lo(unsigned u) { return __uint_as_float(u << 16); }
__device__ __forceinline__ float bf_hi(unsigned u) { return __uint_as_float(u & 0xffff0000u); }
constexpr int MROWS = 32768;
constexpr float LOG2E = 1.4426950408889634f;
__device__ __forceinline__ float sigmoid_f(float x) { return __builtin_amdgcn_rcpf(1.0f + __builtin_amdgcn_exp2f(-x * LOG2E)); }
__device__ __forceinline__ float row_rs(const GAS float* rowss, int row) {
    const GAS f32x4* p = (const GAS f32x4*)(rowss + (size_t)row * 16); const f32x4 a = p[0], b = p[1], c = p[2], d = p[3];
    const float s = ((a[0] + a[1]) + (a[2] + a[3])) + ((b[0] + b[1]) + (b[2] + b[3])) + ((c[0] + c[1]) + (c[2] + c[3])) + ((d[0] + d[1]) + (d[2] + d[3]));
    return __builtin_amdgcn_rsqf(s * (1.0f / 1024.0f) + 1e-6f);
}
struct EpiQKV {
    static constexpr bool PERM = true, AFTER_DRAIN = false, CHAIN = false;
    GAS bf16_t* QKV; const GAS float* rowss; GAS float* ss;
    __device__ __forceinline__ void operator()(const f32x4 (&acc)[2][2][4][2], const Unit& u, int wr, int wc, int fr, int fq) const {
        const int row0 = u.pm * BM + wr * 64 + fr; const int t = u.pn >> 1, colt = (u.pn & 1) * 256;
        GAS bf16_t* base = QKV + (size_t)t * MROWS * 512; const int col0 = colt + wc * 32 + 8 * fq;
        const int sidx = (t == 1) ? 0 : (t == 2) ? 1 : (t == 5) ? 2 : (t == 7) ? 3 : -1;
#pragma unroll
        for (int ai = 0; ai < 2; ++ai)
#pragma unroll
            for (int m = 0; m < 4; ++m) { const int row = row0 + ai * HALF + m * 16; const float rs = row_rs(rowss, row); GAS bf16_t* rowp = base + (size_t)row * 512 + col0;
#pragma unroll
                for (int bj = 0; bj < 2; ++bj) { const f32x4 v0 = acc[ai][bj][m][0] * rs, v1 = acc[ai][bj][m][1] * rs;
                    u32x4 w; w.x = cvt_pk_bf16(v0[0], v0[1]); w.y = cvt_pk_bf16(v0[2], v0[3]); w.z = cvt_pk_bf16(v1[0], v1[1]); w.w = cvt_pk_bf16(v1[2], v1[3]);
                    *(GAS u32x4*)(rowp + bj * HALF) = w;
                    if (sidx >= 0) { float q = ((v0[0] * v0[0] + v0[1] * v0[1]) + (v0[2] * v0[2] + v0[3] * v0[3])) + ((v1[0] * v1[0] + v1[1] * v1[1]) + (v1[2] * v1[2] + v1[3] * v1[3]));
                        q += __shfl_xor(q, 16); q += __shfl_xor(q, 32);
                        if (fq == 0) ss[((size_t)sidx * MROWS + row) * 16 + (colt >> 5) + 4 * bj + wc] = q; } } }
    }
};
struct EpiQKVG {
    static constexpr bool PERM = true, AFTER_DRAIN = false, CHAIN = false;
    EpiQKV q; GAS bf16_t* g01; GAS bf16_t* g2; const GAS float* bias;
    __device__ __forceinline__ void operator()(const f32x4 (&acc)[2][2][4][2], const Unit& u, int wr, int wc, int fr, int fq) const {
        if (u.pn < 18) { q(acc, u, wr, wc, fr, fq); return; }
        const int c = u.pn - 18, br = c >> 2; GAS bf16_t* G = (br < 2) ? g01 + (size_t)br * MROWS * 1024 : g2;
        const int row0 = u.pm * BM + wr * 64 + fr; const int col0 = (c & 3) * BM + wc * 32 + 8 * fq;
        f32x4 bv[2][2];
#pragma unroll
        for (int bj = 0; bj < 2; ++bj)
#pragma unroll
            for (int n = 0; n < 2; ++n) bv[bj][n] = *(const GAS f32x4*)(bias + br * 1024 + col0 + bj * HALF + 4 * n);
#pragma unroll
        for (int ai = 0; ai < 2; ++ai)
#pragma unroll
            for (int m = 0; m < 4; ++m) { const int row = row0 + ai * HALF + m * 16; const float rs = row_rs(q.rowss, row); GAS bf16_t* rowp = G + (size_t)row * 1024 + col0;
#pragma unroll
                for (int bj = 0; bj < 2; ++bj) { const f32x4 v0 = acc[ai][bj][m][0] * rs + bv[bj][0], v1 = acc[ai][bj][m][1] * rs + bv[bj][1];
                    u32x4 w; w.x = cvt_pk_bf16(fmaxf(sigmoid_f(v0[0]), 1e-30f), fmaxf(sigmoid_f(v0[1]), 1e-30f)); w.y = cvt_pk_bf16(fmaxf(sigmoid_f(v0[2]), 1e-30f), fmaxf(sigmoid_f(v0[3]), 1e-30f));
                    w.z = cvt_pk_bf16(fmaxf(sigmoid_f(v1[0]), 1e-30f), fmaxf(sigmoid_f(v1[1]), 1e-30f)); w.w = cvt_pk_bf16(fmaxf(sigmoid_f(v1[2]), 1e-30f), fmaxf(sigmoid_f(v1[3]), 1e-30f));
                    *(GAS u32x4*)(rowp + bj * HALF) = w; } }
    }
};
struct EpiBranch {
    static constexpr bool PERM = true, AFTER_DRAIN = false, CHAIN = true;
    const GAS bf16_t* g01; const GAS bf16_t* g2; GAS bf16_t* Mg;
    __device__ __forceinline__ bool keep(const Unit& u) const { return (u.pm >> 7) < 2; }
    __device__ __forceinline__ void operator()(f32x4 (&acc)[2][2][4][2], const Unit& u, int wr, int wc, int fr, int fq) const {
        const int br = u.pm >> 7, pm = u.pm & 127, pn = u.pn & 3;
        const int row0 = pm * BM + wr * 64 + fr; const int col0 = pn * BM + wc * 32 + 8 * fq;
#pragma unroll
        for (int ai = 0; ai < 2; ++ai)
#pragma unroll
            for (int m = 0; m < 4; ++m) { const int row = row0 + ai * HALF + m * 16; const GAS bf16_t* gp = ((br < 2) ? g01 + (size_t)br * MROWS * 1024 : g2) + (size_t)row * 1024 + col0; const GAS bf16_t* gn = ((br == 0) ? g01 + (size_t)MROWS * 1024 : g2) + (size_t)row * 1024 + col0; GAS bf16_t* mp = Mg + (size_t)row * 1024 + col0;
#pragma unroll
                for (int bj = 0; bj < 2; ++bj) { const u32x4 g = *(const GAS u32x4*)(gp + bj * HALF);
                    f32x4 s0 = {bf_lo(g.x), bf_hi(g.x), bf_lo(g.y), bf_hi(g.y)}, s1 = {bf_lo(g.z), bf_hi(g.z), bf_lo(g.w), bf_hi(g.w)};
                    if (br < 2) { const u32x4 h = *(const GAS u32x4*)(gn + bj * HALF);
                        const f32x4 d0 = {bf_lo(h.x), bf_hi(h.x), bf_lo(h.y), bf_hi(h.y)}, d1 = {bf_lo(h.z), bf_hi(h.z), bf_lo(h.w), bf_hi(h.w)};
#pragma unroll
                        for (int e = 0; e < 4; ++e) { s0[e] *= __builtin_amdgcn_rcpf(fmaxf(d0[e], 1e-30f)); s1[e] *= __builtin_amdgcn_rcpf(fmaxf(d1[e], 1e-30f)); }
                        acc[ai][bj][m][0] *= s0; acc[ai][bj][m][1] *= s1;
                    } else { const f32x4 v0 = acc[ai][bj][m][0] * s0, v1 = acc[ai][bj][m][1] * s1;
                        u32x4 w; w.x = cvt_pk_bf16(v0[0], v0[1]); w.y = cvt_pk_bf16(v0[2], v0[3]); w.z = cvt_pk_bf16(v1[0], v1[1]); w.w = cvt_pk_bf16(v1[2], v1[3]);
                        *(GAS u32x4*)(mp + bj * HALF) = w; } } }
    }
};
struct GateOrder {
    int G, c;
    __device__ bool next(int i, Unit& u) const { const int j = i / 3, br = i - 3 * j; const int pmn = c + j * G; if (pmn >= 512) return false; u.pm = pmn >> 2; u.pn = br * 4 + (pmn & 3); return true; }
    __device__ __forceinline__ void a_ready(const Unit&) const {}
    __device__ __forceinline__ void done(const Unit&) const {}
};
struct BranchOrder {
    int G, c;
    __device__ bool next(int i, Unit& u) const { const int j = i / 3, br = i - 3 * j; int pmn;
        if ((G & 7) == 0 && 512 % G == 0) { const int per = G >> 3, J = 512 / G; if (j >= J) return false; pmn = (c / per) * (per * J) + (c % per) + per * j; } else { pmn = c + j * G; if (pmn >= 512) return false; }
        u.pm = br * 128 + (pmn >> 2); u.pn = br * 4 + (pmn & 3); return true; }
    __device__ __forceinline__ void a_ready(const Unit&) const {}
    __device__ __forceinline__ void done(const Unit&) const {}
};
struct EpiResid {
    static constexpr bool PERM = true, AFTER_DRAIN = false, CHAIN = false;
    GAS float* out; GAS bf16_t* xb; GAS float* rowss;
    __device__ __forceinline__ void operator()(const f32x4 (&acc)[2][2][4][2], const Unit& u, int wr, int wc, int fr, int fq) const {
        const int row0 = u.pm * BM + wr * 64 + fr; const int col0 = u.pn * BM + wc * 32 + 8 * fq;
#pragma unroll
        for (int ai = 0; ai < 2; ++ai)
#pragma unroll
            for (int m = 0; m < 4; ++m) { const int row = row0 + ai * HALF + m * 16; const size_t off = (size_t)row * 1024 + col0; float q = 0.f;
#pragma unroll
                for (int bj = 0; bj < 2; ++bj) { const u32x4 xo = *(const GAS u32x4*)(xb + off + bj * HALF);
                    f32x4 v0 = acc[ai][bj][m][0], v1 = acc[ai][bj][m][1];
                    v0[0] += bf_lo(xo.x); v0[1] += bf_hi(xo.x); v0[2] += bf_lo(xo.y); v0[3] += bf_hi(xo.y); v1[0] += bf_lo(xo.z); v1[1] += bf_hi(xo.z); v1[2] += bf_lo(xo.w); v1[3] += bf_hi(xo.w);
                    if (out) { *(GAS f32x4*)(out + off + bj * HALF) = v0; *(GAS f32x4*)(out + off + bj * HALF + 4) = v1; }
                    u32x4 w; w.x = cvt_pk_bf16(v0[0], v0[1]); w.y = cvt_pk_bf16(v0[2], v0[3]); w.z = cvt_pk_bf16(v1[0], v1[1]); w.w = cvt_pk_bf16(v1[2], v1[3]);
                    if (!out) *(GAS u32x4*)(xb + off + bj * HALF) = w;
                    q += ((v0[0] * v0[0] + v0[1] * v0[1]) + (v0[2] * v0[2] + v0[3] * v0[3])) + ((v1[0] * v1[0] + v1[1] * v1[1]) + (v1[2] * v1[2] + v1[3] * v1[3])); }
                q += __shfl_xor(q, 16); q += __shfl_xor(q, 32);
                if (fq == 0 && !out) rowss[(size_t)row * 16 + u.pn * 4 + wc] = q; }
    }
};
struct EpiSwiGLU {
    static constexpr bool PERM = true, AFTER_DRAIN = false, CHAIN = false;
    GAS bf16_t* H; const GAS float* rowss;
    __device__ __forceinline__ void operator()(const f32x4 (&acc)[2][2][4][2], const Unit& u, int wr, int wc, int fr, int fq) const {
        const int row0 = u.pm * BM + wr * 64 + fr; const int col0 = (u.pn * BM + wc * 32 + 8 * fq) >> 1;
#pragma unroll
        for (int ai = 0; ai < 2; ++ai)
#pragma unroll
            for (int m = 0; m < 4; ++m) { const int row = row0 + ai * HALF + m * 16; const float rs = row_rs(rowss, row); GAS bf16_t* rowp = H + (size_t)row * 2816 + col0;
#pragma unroll
                for (int bj = 0; bj < 2; ++bj) { const f32x4 g = acc[ai][bj][m][0] * rs, uu = acc[ai][bj][m][1] * rs;
                    u32x2 w; w.x = cvt_pk_bf16(g[0] * sigmoid_f(g[0]) * uu[0], g[1] * sigmoid_f(g[1]) * uu[1]); w.y = cvt_pk_bf16(g[2] * sigmoid_f(g[2]) * uu[2], g[3] * sigmoid_f(g[3]) * uu[3]);
                    *(GAS u32x2*)(rowp + bj * (HALF / 2)) = w; } }
    }
};

template <class Epi, class Sched, bool ALIGN_EPI = false, bool SP2 = false>
__device__ __forceinline__ void gemm_phase(PG8_LAS unsigned char* lds, const Gemm g, const Sched& S, const Epi& E) {
    int tid_ = threadIdx.x; asm volatile("" : "+v"(tid_));
    const int tid = tid_, wid = __builtin_amdgcn_readfirstlane(tid >> 6), lane = tid & 63, wr = wid >> 2, wc = wid & 3, fr = lane & 15, fq = lane >> 4;
    const int K = g.K, nt = K / BK;
    unsigned voffA[2], voffB[2];
#pragma unroll
    for (int i = 0; i < 2; ++i) { int R, C; stage_rc(tid * 16 + i * 8192, R, C); const int Rb = Epi::PERM ? ((R & ~31) + perm32(R & 31)) : R;
        voffA[i] = (unsigned)(R * K + C) * 2u; voffB[i] = (unsigned)(Rb * K + C) * 2u; }
    const size_t kstep = (size_t)(BK * 2);
    const size_t hstep = (size_t)HALF * K * 2;
    const size_t tstep = 2 * hstep;
    const unsigned ldsw = (unsigned)wid * 1024u;
    const int aoff = lds_byte(wr * 64 + fr, fq * 8), boff = lds_byte(wc * 32 + fr, fq * 8);
#define PG8_SA(b, h) (((b) * 2 + (h)) * HTB)
#define PG8_SB(b, h) ((4 + (b) * 2 + (h)) * HTB)
#define PG8_STAGE(bufoff, gbase, voff) do { _Pragma("unroll") for (int _i = 0; _i < 2; ++_i) \
        __builtin_amdgcn_global_load_lds((const unsigned*)((const char*)(gbase) + (voff)[_i]), (PG8_LAS unsigned*)(lds + (bufoff) + ldsw + _i * 8192), 16, 0, 0); } while (0)
#define PG8_LDA(dst, b, h) do { _Pragma("unroll") for (int m = 0; m < 4; ++m) _Pragma("unroll") for (int k = 0; k < 2; ++k) dst[m][k] = *(const PG8_LAS bf16x8*)(lds + PG8_SA(b, h) + aoff + m * 2048 + k * 1024); } while (0)
#define PG8_LDB(dst, b, h) do { _Pragma("unroll") for (int n = 0; n < 2; ++n) _Pragma("unroll") for (int k = 0; k < 2; ++k) dst[n][k] = *(const PG8_LAS bf16x8*)(lds + PG8_SB(b, h) + boff + n * 2048 + k * 1024); } while (0)
#define PG8_MMA(ai, bj, At, Bt) do { __builtin_amdgcn_s_setprio(1); _Pragma("unroll") for (int m = 0; m < 4; ++m) _Pragma("unroll") for (int n = 0; n < 2; ++n) _Pragma("unroll") for (int k = 0; k < 2; ++k) \
        acc[ai][bj][m][n] = __builtin_amdgcn_mfma_f32_16x16x32_bf16(Bt[n][k], At[m][k], acc[ai][bj][m][n], 0, 0, 0); __builtin_amdgcn_s_setprio(0); } while (0)
#define PG8_WAIT_V(n) asm volatile("s_waitcnt vmcnt(" #n ")" ::: "memory")
#define PG8_WAIT_L(n) asm volatile("s_waitcnt lgkmcnt(" #n ")" ::: "memory")
#define PG8_BAR __builtin_amdgcn_s_barrier()
#define PG8_SCHED __builtin_amdgcn_sched_barrier(0)
    Unit cur, nxt; int ui = 0;
    if (!S.next(0, cur)) return;
    f32x4 acc[2][2][4][2];
#pragma unroll
    for (int a = 0; a < 2; ++a)
#pragma unroll
        for (int b = 0; b < 2; ++b)
#pragma unroll
            for (int m = 0; m < 4; ++m)
#pragma unroll
                for (int n = 0; n < 2; ++n) acc[a][b][m][n] = (f32x4){0.f, 0.f, 0.f, 0.f};
    bf16x8 At[4][2], B0[2][2], B1[2][2];
    const char* cA = (const char*)g.A + (size_t)cur.pm * tstep; const char* cB = (const char*)g.Bt + (size_t)cur.pn * tstep;
    S.a_ready(cur);
    if constexpr (SP2) {
        PG8_STAGE(PG8_SB(0, 0), cB, voffB); PG8_STAGE(PG8_SB(0, 1), cB + hstep, voffB); PG8_STAGE(PG8_SA(0, 0), cA, voffA); PG8_STAGE(PG8_SA(0, 1), cA + hstep, voffA);
        if (wr == 1) PG8_BAR;
        PG8_WAIT_V(2); PG8_BAR;
        PG8_STAGE(PG8_SB(1, 0), cB + kstep, voffB); PG8_STAGE(PG8_SA(1, 0), cA + kstep, voffA); PG8_STAGE(PG8_SB(1, 1), cB + hstep + kstep, voffB);
        PG8_WAIT_V(6); PG8_BAR;
    } else {
        PG8_STAGE(PG8_SB(0, 0), cB, voffB); PG8_STAGE(PG8_SA(0, 0), cA, voffA); PG8_STAGE(PG8_SB(0, 1), cB + hstep, voffB); PG8_STAGE(PG8_SA(0, 1), cA + hstep, voffA);
        if (wr == 1) PG8_BAR;
        PG8_WAIT_V(4); PG8_BAR;
        PG8_STAGE(PG8_SB(1, 0), cB + kstep, voffB); PG8_STAGE(PG8_SA(1, 0), cA + kstep, voffA); PG8_STAGE(PG8_SB(1, 1), cB + hstep + kstep, voffB);
        PG8_WAIT_V(6); PG8_BAR;
    }
    for (;;) {
        const bool has_next = S.next(ui + 1, nxt);
        const char* nA = has_next ? (const char*)g.A + (size_t)nxt.pm * tstep : cA; const char* nB = has_next ? (const char*)g.Bt + (size_t)nxt.pn * tstep : cB;
        for (int t = 0; t < nt; t += 2) {
            const bool last = (t == nt - 2);
            const char* a1 = cA + (size_t)(t + 1) * kstep;
            const char* a2 = last ? nA : cA + (size_t)(t + 2) * kstep; const char* b2 = last ? nB : cB + (size_t)(t + 2) * kstep;
            const char* a3 = a2 + kstep; const char* b3 = b2 + kstep;
            if (last && has_next) S.a_ready(nxt);
            if constexpr (SP2) {
            PG8_LDB(B0, 0, 0); PG8_LDB(B1, 0, 1); PG8_SCHED; PG8_LDA(At, 0, 0); PG8_STAGE(PG8_SA(1, 1), a1 + hstep, voffA);
            PG8_WAIT_V(8); PG8_WAIT_L(0); PG8_BAR; PG8_MMA(0, 0, At, B0); PG8_MMA(0, 1, At, B1); PG8_BAR; PG8_SCHED;
            PG8_LDA(At, 0, 1); PG8_STAGE(PG8_SB(0, 0), b2, voffB); PG8_STAGE(PG8_SB(0, 1), b2 + hstep, voffB); PG8_STAGE(PG8_SA(0, 0), a2, voffA);
            PG8_WAIT_V(8); PG8_WAIT_L(0); PG8_BAR; PG8_MMA(1, 0, At, B0); PG8_MMA(1, 1, At, B1); PG8_BAR; PG8_SCHED;
            PG8_LDB(B0, 1, 0); PG8_LDB(B1, 1, 1); PG8_SCHED; PG8_LDA(At, 1, 0); PG8_STAGE(PG8_SA(0, 1), a2 + hstep, voffA);
            PG8_WAIT_V(8); PG8_WAIT_L(0); PG8_BAR; PG8_MMA(0, 0, At, B0); PG8_MMA(0, 1, At, B1); PG8_BAR; PG8_SCHED;
            PG8_LDA(At, 1, 1); PG8_STAGE(PG8_SB(1, 0), b3, voffB); PG8_STAGE(PG8_SB(1, 1), b3 + hstep, voffB); PG8_STAGE(PG8_SA(1, 0), a3, voffA);
            PG8_WAIT_V(8); PG8_WAIT_L(0); PG8_BAR; PG8_MMA(1, 0, At, B0); PG8_MMA(1, 1, At, B1); PG8_BAR; PG8_SCHED;
            } else {
            PG8_LDB(B0, 0, 0); PG8_SCHED; PG8_LDA(At, 0, 0); PG8_STAGE(PG8_SA(1, 1), a1 + hstep, voffA);
            PG8_WAIT_L(8); PG8_BAR; PG8_WAIT_L(0); PG8_MMA(0, 0, At, B0); PG8_BAR; PG8_SCHED;
            PG8_LDB(B1, 0, 1); PG8_STAGE(PG8_SB(0, 0), b2, voffB);
            PG8_BAR; PG8_WAIT_L(0); PG8_MMA(0, 1, At, B1); PG8_BAR;
            PG8_LDA(At, 0, 1); PG8_STAGE(PG8_SA(0, 0), a2, voffA);
            PG8_BAR; PG8_WAIT_L(0); PG8_MMA(1, 0, At, B0); PG8_BAR; PG8_SCHED;
            PG8_STAGE(PG8_SB(0, 1), b2 + hstep, voffB);
            PG8_WAIT_V(6); PG8_BAR; PG8_MMA(1, 1, At, B1); PG8_BAR;
            PG8_LDB(B0, 1, 0); PG8_SCHED; PG8_LDA(At, 1, 0); PG8_STAGE(PG8_SA(0, 1), a2 + hstep, voffA);
            PG8_WAIT_L(8); PG8_BAR; PG8_WAIT_L(0); PG8_MMA(0, 0, At, B0); PG8_BAR; PG8_SCHED;
            PG8_LDB(B1, 1, 1); PG8_STAGE(PG8_SB(1, 0), b3, voffB);
            PG8_BAR; PG8_WAIT_L(0); PG8_MMA(0, 1, At, B1); PG8_BAR;
            PG8_LDA(At, 1, 1); PG8_STAGE(PG8_SA(1, 0), a3, voffA);
            PG8_BAR; PG8_WAIT_L(0); PG8_MMA(1, 0, At, B0); PG8_BAR; PG8_SCHED;
            PG8_STAGE(PG8_SB(1, 1), b3 + hstep, voffB);
            PG8_WAIT_V(6); PG8_BAR; PG8_MMA(1, 1, At, B1); PG8_BAR;
            }
        }
        if constexpr (ALIGN_EPI) { if (wr == 0) PG8_BAR; }
        if constexpr (!Epi::AFTER_DRAIN) { E(acc, cur, wr, wc, fr, fq); S.done(cur); }
        if (!has_next) break;
        bool keep_ = false; if constexpr (Epi::CHAIN) keep_ = E.keep(cur);
        if (!keep_) {
#pragma unroll
        for (int a = 0; a < 2; ++a)
#pragma unroll
            for (int b = 0; b < 2; ++b)
#pragma unroll
                for (int m = 0; m < 4; ++m)
#pragma unroll
                    for (int n = 0; n < 2; ++n) acc[a][b][m][n] = (f32x4){0.f, 0.f, 0.f, 0.f};
        }
        cur = nxt; cA = nA; cB = nB; ++ui;
        if constexpr (ALIGN_EPI) { if (wr == 1) PG8_BAR; }
    }
    PG8_WAIT_V(0);
    if constexpr (!ALIGN_EPI) { if (wr == 0) PG8_BAR; }
    PG8_BAR;
    if constexpr (Epi::AFTER_DRAIN) { E.fused(acc, cur, wr, wc, fr, fq, lds, wid, lane); S.done(cur); }
#undef PG8_SA
#undef PG8_SB
#undef PG8_STAGE
#undef PG8_LDA
#undef PG8_LDB
#undef PG8_MMA
#undef PG8_WAIT_V
#undef PG8_WAIT_L
#undef PG8_BAR
#undef PG8_SCHED
}
}
namespace att {
#define LAS __attribute__((address_space(3)))
typedef unsigned short bf16_t;
typedef short bf16x8 __attribute__((ext_vector_type(8)));
typedef short s16x4 __attribute__((ext_vector_type(4)));
typedef short v4i16_t __attribute__((ext_vector_type(4)));
typedef float f32x16 __attribute__((ext_vector_type(16)));
typedef float f32x4 __attribute__((ext_vector_type(4)));
typedef unsigned u32x4 __attribute__((ext_vector_type(4)));
typedef unsigned u32x2 __attribute__((ext_vector_type(2)));
constexpr int SEQ = 2048, PITCH = 512, MROWS = 32768;
constexpr size_t BUF = (size_t)MROWS * 512;
constexpr float LOG2E = 1.4426950408889634f, C2 = 0.125f * LOG2E;
constexpr int TAB_OFF = 65536, BC_OFF = 131072 + 512, FL_OFF = BC_OFF + 64, PRM_OFF = 131072 + 4096;
using pg8::cvt_pk_bf16; using pg8::bf_lo; using pg8::bf_hi;
#define WG_BAR() do { asm volatile("s_waitcnt lgkmcnt(0)" ::: "memory"); __builtin_amdgcn_s_barrier(); asm volatile("" ::: "memory"); } while (0)
#define MFMA32(a, b, c) __builtin_amdgcn_mfma_f32_32x32x16_bf16((a), (b), (c), 0, 0, 0)
__device__ __forceinline__ s16x4 vtr(const LAS unsigned char* p) { return __builtin_bit_cast(s16x4, __builtin_amdgcn_ds_read_tr16_b64_v4i16((LAS v4i16_t*)p)); }
__device__ __forceinline__ u32x4 scale8(u32x4 v, float s) { u32x4 o; o.x = cvt_pk_bf16(bf_lo(v.x) * s, bf_hi(v.x) * s); o.y = cvt_pk_bf16(bf_lo(v.y) * s, bf_hi(v.y) * s); o.z = cvt_pk_bf16(bf_lo(v.z) * s, bf_hi(v.z) * s); o.w = cvt_pk_bf16(bf_lo(v.w) * s, bf_hi(v.w) * s); return o; }
__device__ __forceinline__ bf16x8 pack8(const f32x16& p, int s) { u32x4 w; w.x = cvt_pk_bf16(p[8 * s], p[8 * s + 1]); w.y = cvt_pk_bf16(p[8 * s + 2], p[8 * s + 3]); w.z = cvt_pk_bf16(p[8 * s + 4], p[8 * s + 5]); w.w = cvt_pk_bf16(p[8 * s + 6], p[8 * s + 7]); return __builtin_bit_cast(bf16x8, w); }
__device__ __forceinline__ float wave_sum(float v) {
#pragma unroll
    for (int o = 1; o < 64; o <<= 1) v += __shfl_xor(v, o);
    return v; }
struct AttnArgs { GAS bf16_t* qkv; GAS bf16_t* obase; const GAS float* ss; const GAS float* qk_g_diff; const GAS float* lambda_qk; const GAS float* subln_g; const GAS float* qk_g_ch; const GAS float* rel_bias; float lam_init; };

__device__ __forceinline__ void qkt(f32x16& p0, f32x16& p1, const LAS unsigned char* kimg, const bf16x8* qr, int r32, int hi, float cinit = 0.f) {
    const LAS unsigned char* kb = kimg + hi * 1024 + r32 * 16;
#pragma unroll
    for (int r = 0; r < 16; ++r) { p0[r] = cinit; p1[r] = cinit; }
    bf16x8 kf[8];
#pragma unroll
    for (int d0 = 0; d0 < 4; ++d0) { kf[2 * d0] = *(const LAS bf16x8*)(kb + d0 * 2048); kf[2 * d0 + 1] = *(const LAS bf16x8*)(kb + d0 * 2048 + 512); }
    __builtin_amdgcn_sched_barrier(0);
#pragma unroll
    for (int d0 = 0; d0 < 4; ++d0) { p0 = MFMA32(kf[2 * d0], qr[d0], p0); p1 = MFMA32(kf[2 * d0 + 1], qr[d0], p1); }
    __builtin_amdgcn_sched_barrier(0);
}
template <int NB> __device__ __forceinline__ void pv(f32x16* o, const LAS unsigned char* vimg, int vl, const f32x16& p0, const f32x16& p1) {
    const bf16x8 pf[4] = {pack8(p0, 0), pack8(p0, 1), pack8(p1, 0), pack8(p1, 1)};
    s16x4 lo[2][4], hh[2][4];
#pragma unroll
    for (int ks = 0; ks < 4; ++ks) { const LAS unsigned char* vp = vimg + vl + ks * 1024; lo[0][ks] = vtr(vp); hh[0][ks] = vtr(vp + 512); }
#pragma unroll
    for (int blk = 0; blk < NB; ++blk) {
        if (blk + 1 < NB) {
#pragma unroll
            for (int ks = 0; ks < 4; ++ks) { const LAS unsigned char* vp = vimg + vl + (blk + 1) * 4096 + ks * 1024; lo[(blk + 1) & 1][ks] = vtr(vp); hh[(blk + 1) & 1][ks] = vtr(vp + 512); } }
        __builtin_amdgcn_sched_barrier(0);
#pragma unroll
        for (int ks = 0; ks < 4; ++ks) { const s16x4 a = lo[blk & 1][ks], b = hh[blk & 1][ks];
            const bf16x8 vf = (bf16x8){a[0], a[1], a[2], a[3], b[0], b[1], b[2], b[3]};
            o[blk] = MFMA32(vf, pf[ks], o[blk]); }
        __builtin_amdgcn_sched_barrier(0);
    }
}
__device__ __forceinline__ void qkt_half(f32x16& p, const LAS unsigned char* kimg, const bf16x8* qr, int r32, int hi, float cinit, int half) {
    const LAS unsigned char* kb = kimg + hi * 1024 + r32 * 16 + half * 512;
#pragma unroll
    for (int r = 0; r < 16; ++r) p[r] = cinit;
    bf16x8 kf[4];
#pragma unroll
    for (int d0 = 0; d0 < 4; ++d0) kf[d0] = *(const LAS bf16x8*)(kb + d0 * 2048);
#pragma unroll
    for (int d0 = 0; d0 < 4; ++d0) p = MFMA32(kf[d0], qr[d0], p);
}
template <int NB> __device__ __forceinline__ void pv_half(f32x16* o, const LAS unsigned char* vimg, int vl, const f32x16& p, int half) {
    const bf16x8 pf[2] = {pack8(p, 0), pack8(p, 1)};
#pragma unroll
    for (int blk = 0; blk < NB; ++blk) { s16x4 lo[2], hh[2];
#pragma unroll
        for (int ks = 0; ks < 2; ++ks) { const LAS unsigned char* vp = vimg + vl + blk * 4096 + (2 * half + ks) * 1024; lo[ks] = vtr(vp); hh[ks] = vtr(vp + 512); }
#pragma unroll
        for (int ks = 0; ks < 2; ++ks) { const bf16x8 vf = (bf16x8){lo[ks][0], lo[ks][1], lo[ks][2], lo[ks][3], hh[ks][0], hh[ks][1], hh[ks][2], hh[ks][3]};
            o[blk] = MFMA32(vf, pf[ks], o[blk]); } }
}
template <int NB> __device__ __forceinline__ void store_o(GAS bf16_t* orow, const f32x16* o, int hi) {
#pragma unroll
    for (int blk = 0; blk < NB; ++blk)
#pragma unroll
        for (int i = 0; i < 4; ++i) { u32x2 w; w.x = cvt_pk_bf16(o[blk][4 * i], o[blk][4 * i + 1]); w.y = cvt_pk_bf16(o[blk][4 * i + 2], o[blk][4 * i + 3]);
            *(GAS u32x2*)(orow + blk * 32 + 8 * i + 4 * hi) = w; }
}

template <int VAR, bool FIX> __device__ __forceinline__ void unit_ac(const AttnArgs& A, int b, int h, int qb, LAS unsigned char* lds, float shift) {
    int tid_ = threadIdx.x; asm volatile("" : "+v"(tid_));
    const int tid = tid_, lane = tid & 63, r32 = lane & 31, hi = lane >> 5; const int wid = __builtin_amdgcn_readfirstlane(tid >> 6);
    const size_t rowbase = (size_t)b * SEQ; const int q0 = qb * 256;
    if (wid < 4) __builtin_amdgcn_s_setprio(2); else __builtin_amdgcn_s_setprio(0);
    GAS bf16_t* qkv_ = A.qkv; const GAS float* ss_ = A.ss; asm volatile("" : "+s"(qkv_), "+s"(ss_));
    GAS bf16_t* Qb = qkv_ + (VAR == 0 ? 0 : 2) * BUF; const GAS bf16_t* Kb = qkv_ + (VAR == 0 ? 3 : 7) * BUF; const GAS bf16_t* Vb = qkv_ + (VAR == 0 ? 4 : 8) * BUF;
    const GAS float* ssq = ss_ + (size_t)1 * MROWS * 16; const GAS float* ssk = ss_ + (size_t)3 * MROWS * 16;
    const int qrow = q0 + wid * 32 + r32;
    bf16x8 qr[4];
    { const GAS bf16_t* qp = Qb + (rowbase + qrow) * PITCH + h * 64; float qs = C2;
      if (VAR == 2) { const GAS float* s = ssq + (rowbase + qrow) * 16 + 2 * h; qs = C2 * __builtin_amdgcn_rsqf((s[0] + s[1]) * (1.0f / 64.0f) + 1e-6f); }
#pragma unroll
      for (int d0 = 0; d0 < 4; ++d0) { const u32x4 raw = *(const GAS u32x4*)(qp + d0 * 16 + hi * 8); u32x4 w;
          if (VAR == 2) { const LAS float* g = (const LAS float*)(lds + PRM_OFF) + 96 + d0 * 16 + hi * 8; const f32x4 a0 = *(const LAS f32x4*)g * qs, a1 = *(const LAS f32x4*)(g + 4) * qs;
              w.x = cvt_pk_bf16(bf_lo(raw.x) * a0[0], bf_hi(raw.x) * a0[1]); w.y = cvt_pk_bf16(bf_lo(raw.y) * a0[2], bf_hi(raw.y) * a0[3]);
              w.z = cvt_pk_bf16(bf_lo(raw.z) * a1[0], bf_hi(raw.z) * a1[1]); w.w = cvt_pk_bf16(bf_lo(raw.w) * a1[2], bf_hi(raw.w) * a1[3]); }
          else w = scale8(raw, qs);
          qr[d0] = __builtin_bit_cast(bf16x8, w); } }
    const int t_hi = 4 * qb + 3, t_lo = (VAR == 0) ? 0 : ((4 * qb - 8) > 0 ? (4 * qb - 8) : 0), nT = t_hi - t_lo + 1;
    const int tw = 4 * qb + (wid >> 1);
    if (VAR == 2) { LAS float* T = (LAS float*)(lds + TAB_OFF);
        for (int j = tid; j < 640; j += 512) { int d = j - 63; d = d < -128 ? -128 : (d > 128 ? 128 : d); T[j] = A.rel_bias[h * 257 + d + 128] * LOG2E; } }
    const GAS bf16_t* ksrc = Kb + (rowbase + lane) * PITCH + h * 64 + wid * 8;
    const GAS bf16_t* vsrc = Vb + (rowbase + 16 * (wid & 3) + (lane >> 2)) * PITCH + h * 64 + (wid >> 2) * 32 + (lane & 3) * 8;
    const GAS float* ksst = ssk + (rowbase + lane) * 16 + 2 * h;
    const int sdst = wid * 1024 + lane * 16;
    u32x4 kreg, vreg;
    float ks0 = 0.f, ks1 = 0.f;
#define LOAD_T(t) do { kreg = *(const GAS u32x4*)(ksrc + (size_t)(t) * 64 * PITCH); vreg = *(const GAS u32x4*)(vsrc + (size_t)(t) * 64 * PITCH); \
        if (VAR == 2) { const GAS float* s_ = ksst + (size_t)(t) * 64 * 16; ks0 = s_[0]; ks1 = s_[1]; } } while (0)
#define WRITE_T(st) do { if (VAR == 2) kreg = scale8(kreg, __builtin_amdgcn_rsqf((ks0 + ks1) * (1.0f / 64.0f) + 1e-6f)); \
        *(LAS u32x4*)(lds + (st) * 16384 + sdst) = kreg; *(LAS u32x4*)(lds + (st) * 16384 + 8192 + sdst) = vreg; } while (0)
#define TILE(i) ((VAR == 0) ? (t_hi - (i)) : (t_lo + (i)))
    const int vl = (4 * hi + ((lane & 15) >> 2)) * 64 + ((lane >> 4) & 1) * 32 + (lane & 3) * 8;
    f32x16 o[2]; o[0] = f32x16{}; o[1] = f32x16{};
    float m_run = -1e30f, l_run = 0.f, pc = 1.0f;
    LOAD_T(TILE(0)); WRITE_T(0); WG_BAR();
    for (int i = 0; i < nT; ++i) {
        const int t = TILE(i); const int st = i & 1;
        if (i + 1 < nT) LOAD_T(TILE(i + 1));
        const bool wdone = (VAR == 0) && (__builtin_amdgcn_ballot_w64(pc != 0.0f) == 0ull);
        const bool active = (VAR == 0) ? (t <= tw && !wdone) : (t <= tw && t >= tw - 8);
        if (active) {
            f32x16 p0, p1;
            if (VAR == 2 && FIX) {
                const LAS float* T = (const LAS float*)(lds + TAB_OFF);
                const bool far = (t <= tw - 3);
                const LAS unsigned char* kimg = lds + st * 16384; const LAS unsigned char* vimg = lds + st * 16384 + 8192;
                const LAS float* Tq = T + (qrow + 63 - 64 * t - 4 * hi);
                float sum0 = 0.f, sum1 = 0.f;
                if (far) {
                    const float ci = T[639] - shift;
                    qkt_half(p0, kimg, qr, r32, hi, ci, 0); qkt_half(p1, kimg, qr, r32, hi, ci, 1);
#pragma unroll
                    for (int r = 0; r < 16; ++r) { p0[r] = __builtin_amdgcn_exp2f(p0[r]); sum0 += p0[r]; }
                    pv_half<2>(o, vimg, vl, p0, 0);
#pragma unroll
                    for (int r = 0; r < 16; ++r) { p1[r] = __builtin_amdgcn_exp2f(p1[r]); sum1 += p1[r]; }
                    pv_half<2>(o, vimg, vl, p1, 1);
                } else {
                    qkt_half(p0, kimg, qr, r32, hi, -shift, 0); qkt_half(p1, kimg, qr, r32, hi, -shift, 1);
#pragma unroll
                    for (int r = 0; r < 16; ++r) { const int kk = (r & 3) + 8 * (r >> 2); p0[r] = __builtin_amdgcn_exp2f(p0[r] + Tq[-kk]); sum0 += p0[r]; }
                    pv_half<2>(o, vimg, vl, p0, 0);
#pragma unroll
                    for (int r = 0; r < 16; ++r) { const int kk = (r & 3) + 8 * (r >> 2); p1[r] = __builtin_amdgcn_exp2f(p1[r] + Tq[-kk - 32]); sum1 += p1[r]; }
                    pv_half<2>(o, vimg, vl, p1, 1);
                }
                l_run += sum0 + sum1;
            } else if (VAR == 2) {
                qkt(p0, p1, lds + st * 16384, qr, r32, hi);
                const LAS float* T = (const LAS float*)(lds + TAB_OFF) + (qrow + 63 - 64 * t - 4 * hi);
#pragma unroll
                for (int r = 0; r < 16; ++r) { const int kk = (r & 3) + 8 * (r >> 2); p0[r] += T[-kk]; p1[r] += T[-kk - 32]; }
                float mx = p0[0];
#pragma unroll
                for (int r = 1; r < 16; ++r) mx = fmaxf(mx, p0[r]);
#pragma unroll
                for (int r = 0; r < 16; ++r) mx = fmaxf(mx, p1[r]);
                mx = fmaxf(mx, __shfl_xor(mx, 32));
                const float mn = fmaxf(m_run, mx), alpha = __builtin_amdgcn_exp2f(m_run - mn); m_run = mn;
                float sum = 0.f;
#pragma unroll
                for (int r = 0; r < 16; ++r) { p0[r] = __builtin_amdgcn_exp2f(p0[r] - mn); p1[r] = __builtin_amdgcn_exp2f(p1[r] - mn); sum += p0[r] + p1[r]; }
                l_run = l_run * alpha + sum;
#pragma unroll
                for (int r = 0; r < 16; ++r) { o[0][r] *= alpha; o[1][r] *= alpha; }
            } else {
                qkt(p0, p1, lds + st * 16384, qr, r32, hi);
                const bool diag = (t == tw); const int qd = (wid & 1) * 32 + r32;
                float G[16];
#pragma unroll
                for (int p = 0; p < 2; ++p)
#pragma unroll
                    for (int i4 = 0; i4 < 4; ++i4) { float rr[4];
#pragma unroll
                        for (int j = 0; j < 4; ++j) { const float z = p ? p1[4 * i4 + j] : p0[4 * i4 + j]; float rv = __builtin_amdgcn_rcpf(1.0f + __builtin_amdgcn_exp2f(fminf(z, 80.f)));
                            if (diag) { const int kk = 32 * p + 8 * i4 + 4 * hi + j; if (kk >= qd) rv = 1.0f; }
                            rr[j] = rv; }
                        const float sc = rr[3], sb = rr[3] * rr[2], sa = sb * rr[1], R = sa * rr[0];
                        const float w0 = (1.0f - rr[0]) * sa, w1 = (1.0f - rr[1]) * sb, w2 = (1.0f - rr[2]) * sc, w3 = (1.0f - rr[3]);
                        if (p) { p1[4 * i4] = w0; p1[4 * i4 + 1] = w1; p1[4 * i4 + 2] = w2; p1[4 * i4 + 3] = w3; } else { p0[4 * i4] = w0; p0[4 * i4 + 1] = w1; p0[4 * i4 + 2] = w2; p0[4 * i4 + 3] = w3; }
                        const float Ro = __shfl_xor(R, 32);
                        G[2 * (4 * p + i4)] = hi ? Ro : R; G[2 * (4 * p + i4) + 1] = hi ? R : Ro; }
                float Ee[8], Eo[8]; Eo[7] = pc;
#pragma unroll
                for (int q = 7; q >= 0; --q) { Ee[q] = Eo[q] * G[2 * q + 1]; if (q > 0) Eo[q - 1] = Ee[q] * G[2 * q]; }
                pc = Ee[0] * G[0];
#pragma unroll
                for (int q = 0; q < 8; ++q) { const float e = hi ? Eo[q] : Ee[q];
#pragma unroll
                    for (int j = 0; j < 4; ++j) { if (q < 4) p0[4 * q + j] *= e; else p1[4 * (q - 4) + j] *= e; } }
            }
            if (!(VAR == 2 && FIX)) pv<2>(o, lds + st * 16384 + 8192, vl, p0, p1);
        }
        if (i + 1 < nT) WRITE_T(st ^ 1);
        if (VAR == 0) { const bool wd2 = (__builtin_amdgcn_ballot_w64(pc != 0.0f) == 0ull); if (lane == 0) ((LAS unsigned*)(lds + FL_OFF))[st * 8 + wid] = wd2 ? 1u : 0u; }
        WG_BAR();
        if (VAR == 0) { const LAS unsigned* fl = (const LAS unsigned*)(lds + FL_OFF) + st * 8; const unsigned all = fl[0] & fl[1] & fl[2] & fl[3] & fl[4] & fl[5] & fl[6] & fl[7];
            if (__builtin_amdgcn_readfirstlane(all)) break; }
    }
    if (VAR == 2) { const float lt = l_run + __shfl_xor(l_run, 32), inv = __builtin_amdgcn_rcpf(lt);
#pragma unroll
        for (int r = 0; r < 16; ++r) { o[0][r] *= inv; o[1][r] *= inv; } }
    store_o<2>(A.obase + (VAR == 0 ? 0 : 2) * BUF + (rowbase + qrow) * PITCH + h * 64, o, hi);
#undef LOAD_T
#undef WRITE_T
#undef TILE
}

__device__ __forceinline__ void unit_a4(const AttnArgs& A, int b, int hg, int c, LAS unsigned char* lds) {
    int tid_ = threadIdx.x; asm volatile("" : "+v"(tid_));
    const int tid = tid_, lane = tid & 63, r32 = lane & 31, hi = lane >> 5; const int wid = __builtin_amdgcn_readfirstlane(tid >> 6);
    const int hh = wid >> 1, h = 4 * hg + hh;
    const size_t rowbase = (size_t)b * SEQ;
    if (wid < 4) __builtin_amdgcn_s_setprio(2); else __builtin_amdgcn_s_setprio(0);
    GAS bf16_t* qkv_ = A.qkv; asm volatile("" : "+s"(qkv_));
    GAS bf16_t* Qb = qkv_; const GAS bf16_t* Kb = qkv_ + 3 * BUF; const GAS bf16_t* Vb = qkv_ + 4 * BUF;
    const int qd = (wid & 1) * 32 + r32, qrow = 64 * c + qd;
    bf16x8 qr[4];
    { const GAS bf16_t* qp = Qb + (rowbase + qrow) * PITCH + h * 64;
#pragma unroll
      for (int d0 = 0; d0 < 4; ++d0) qr[d0] = __builtin_bit_cast(bf16x8, scale8(*(const GAS u32x4*)(qp + d0 * 16 + hi * 8), C2)); }
    const GAS bf16_t* ksrc = Kb + (rowbase + lane) * PITCH + hg * 256 + wid * 8;
    const GAS bf16_t* vsrc = Vb + (rowbase + 16 * (wid & 3) + (lane >> 2)) * PITCH + hg * 256 + (wid >> 2) * 32 + (lane & 3) * 8;
    const int sdst = wid * 1024 + lane * 16;
    u32x4 kr[4], vr[4];
#define LOAD_T(t) do { const size_t o_ = (size_t)(t) * 64 * PITCH; _Pragma("unroll") for (int j = 0; j < 4; ++j) { kr[j] = *(const GAS u32x4*)(ksrc + o_ + j * 64); vr[j] = *(const GAS u32x4*)(vsrc + o_ + j * 64); } } while (0)
#define WRITE_T(st) do { _Pragma("unroll") for (int j = 0; j < 4; ++j) { *(LAS u32x4*)(lds + (st) * 65536 + j * 8192 + sdst) = kr[j]; *(LAS u32x4*)(lds + (st) * 65536 + 32768 + j * 8192 + sdst) = vr[j]; } } while (0)
    const int vl = (4 * hi + ((lane & 15) >> 2)) * 64 + ((lane >> 4) & 1) * 32 + (lane & 3) * 8;
    f32x16 o[2]; o[0] = f32x16{}; o[1] = f32x16{};
    float pc = 1.0f;
    const int nT = c + 1;
    LOAD_T(c); WRITE_T(0); WG_BAR();
    for (int i = 0; i < nT; ++i) {
        const int t = c - i; const int st = i & 1;
        if (i + 1 < nT) LOAD_T(t - 1);
        const bool wdone = (__builtin_amdgcn_ballot_w64(pc != 0.0f) == 0ull);
        if (!wdone) {
            f32x16 p0, p1; qkt(p0, p1, lds + st * 65536 + hh * 8192, qr, r32, hi);
            const bool diag = (i == 0);
            float G[16];
#pragma unroll
            for (int p = 0; p < 2; ++p)
#pragma unroll
                for (int i4 = 0; i4 < 4; ++i4) { float rr[4];
#pragma unroll
                    for (int j = 0; j < 4; ++j) { const float z = p ? p1[4 * i4 + j] : p0[4 * i4 + j]; float rv = __builtin_amdgcn_rcpf(1.0f + __builtin_amdgcn_exp2f(fminf(z, 80.f)));
                        if (diag) { const int kk = 32 * p + 8 * i4 + 4 * hi + j; if (kk >= qd) rv = 1.0f; }
                        rr[j] = rv; }
                    const float sc = rr[3], sb = rr[3] * rr[2], sa = sb * rr[1], R = sa * rr[0];
                    const float w0 = (1.0f - rr[0]) * sa, w1 = (1.0f - rr[1]) * sb, w2 = (1.0f - rr[2]) * sc, w3 = (1.0f - rr[3]);
                    if (p) { p1[4 * i4] = w0; p1[4 * i4 + 1] = w1; p1[4 * i4 + 2] = w2; p1[4 * i4 + 3] = w3; } else { p0[4 * i4] = w0; p0[4 * i4 + 1] = w1; p0[4 * i4 + 2] = w2; p0[4 * i4 + 3] = w3; }
                    const float Ro = __shfl_xor(R, 32);
                    G[2 * (4 * p + i4)] = hi ? Ro : R; G[2 * (4 * p + i4) + 1] = hi ? R : Ro; }
            float Ee[8], Eo[8]; Eo[7] = pc;
#pragma unroll
            for (int q = 7; q >= 0; --q) { Ee[q] = Eo[q] * G[2 * q + 1]; if (q > 0) Eo[q - 1] = Ee[q] * G[2 * q]; }
            pc = Ee[0] * G[0];
#pragma unroll
            for (int q = 0; q < 8; ++q) { const float e = hi ? Eo[q] : Ee[q];
#pragma unroll
                for (int j = 0; j < 4; ++j) { if (q < 4) p0[4 * q + j] *= e; else p1[4 * (q - 4) + j] *= e; } }
            pv<2>(o, lds + st * 65536 + 32768 + hh * 8192, vl, p0, p1);
        }
        if (i + 1 < nT) WRITE_T(st ^ 1);
        { const bool wd2 = (__builtin_amdgcn_ballot_w64(pc != 0.0f) == 0ull); if (lane == 0) ((LAS unsigned*)(lds + FL_OFF))[st * 8 + wid] = wd2 ? 1u : 0u; }
        WG_BAR();
        { const LAS unsigned* fl = (const LAS unsigned*)(lds + FL_OFF) + st * 8; const unsigned all = fl[0] & fl[1] & fl[2] & fl[3] & fl[4] & fl[5] & fl[6] & fl[7];
          if (__builtin_amdgcn_readfirstlane(all)) break; }
    }
    store_o<2>(A.obase + (rowbase + qrow) * PITCH + h * 64, o, hi);
#undef LOAD_T
#undef WRITE_T
}

__device__ __forceinline__ void unit_b(const AttnArgs& A, int b, int h, int qb, LAS unsigned char* lds) {
    int tid_ = threadIdx.x; asm volatile("" : "+v"(tid_));
    const int tid = tid_, lane = tid & 63, r32 = lane & 31, hi = lane >> 5; const int wid = __builtin_amdgcn_readfirstlane(tid >> 6);
    const int mp = wid >> 2, g4 = wid & 3;
    if (wid < 4) __builtin_amdgcn_s_setprio(2); else __builtin_amdgcn_s_setprio(0);
    const size_t rowbase = (size_t)b * SEQ; const int q0 = qb * 128;
    GAS bf16_t* qkv_ = A.qkv; const GAS float* ss_ = A.ss; asm volatile("" : "+s"(qkv_), "+s"(ss_));
    GAS bf16_t* Qb = qkv_ + 1 * BUF; const GAS bf16_t* Kb = qkv_ + 5 * BUF; const GAS bf16_t* Vb = qkv_ + 6 * BUF;
    const GAS float* ssq = ss_; const GAS float* ssk = ss_ + (size_t)2 * MROWS * 16;
    const int qrow = q0 + g4 * 32 + r32;
    const LAS float* prm = (const LAS float*)(lds + PRM_OFF); const float lam = prm[0], M0 = prm[1];
    bf16x8 qr[4];
    { const GAS bf16_t* qp = Qb + (rowbase + qrow) * PITCH + h * 128 + mp * 64; const GAS float* s = ssq + (rowbase + qrow) * 16 + 4 * h + 2 * mp;
      const float qs = C2 * __builtin_amdgcn_rsqf((s[0] + s[1]) * (1.0f / 64.0f) + 1e-6f);
#pragma unroll
      for (int d0 = 0; d0 < 4; ++d0) { const u32x4 raw = *(const GAS u32x4*)(qp + d0 * 16 + hi * 8); u32x4 w;
          const LAS float* g = prm + 32 + d0 * 16 + hi * 8; const f32x4 a0 = *(const LAS f32x4*)g * qs, a1 = *(const LAS f32x4*)(g + 4) * qs;
          w.x = cvt_pk_bf16(bf_lo(raw.x) * a0[0], bf_hi(raw.x) * a0[1]); w.y = cvt_pk_bf16(bf_lo(raw.y) * a0[2], bf_hi(raw.y) * a0[3]);
          w.z = cvt_pk_bf16(bf_lo(raw.z) * a1[0], bf_hi(raw.z) * a1[1]); w.w = cvt_pk_bf16(bf_lo(raw.w) * a1[2], bf_hi(raw.w) * a1[3]);
          qr[d0] = __builtin_bit_cast(bf16x8, w); } }
    const int nT = 2 * qb + 2; const int tw = 2 * qb + (g4 >> 1);
    const float slope2 = LOG2E * exp2f(-2.0f * (float)(h + 1));
    const GAS bf16_t* ksrc = Kb + (rowbase + lane) * PITCH + h * 128 + wid * 8;
    const GAS bf16_t* vsrc0 = Vb + (rowbase + 16 * (wid & 3) + (lane >> 2)) * PITCH + h * 128 + (wid >> 2) * 32 + (lane & 3) * 8;
    const GAS float* ksst = ssk + (rowbase + lane) * 16 + 4 * h;
    const int sdst = wid * 1024 + lane * 16;
    u32x4 k0r, k1r, v0r, v1r;
    f32x4 kss = {0.f, 0.f, 0.f, 0.f};
#define LOAD_T(t) do { const size_t o_ = (size_t)(t) * 64 * PITCH; k0r = *(const GAS u32x4*)(ksrc + o_); k1r = *(const GAS u32x4*)(ksrc + o_ + 64); v0r = *(const GAS u32x4*)(vsrc0 + o_); v1r = *(const GAS u32x4*)(vsrc0 + o_ + 64); \
        kss = *(const GAS f32x4*)(ksst + (size_t)(t) * 64 * 16); } while (0)
#define WRITE_T(st) do { LAS unsigned char* d_ = lds + (st) * 32768 + sdst; k0r = scale8(k0r, __builtin_amdgcn_rsqf((kss[0] + kss[1]) * (1.0f / 64.0f) + 1e-6f)); k1r = scale8(k1r, __builtin_amdgcn_rsqf((kss[2] + kss[3]) * (1.0f / 64.0f) + 1e-6f)); *(LAS u32x4*)(d_) = k0r; *(LAS u32x4*)(d_ + 8192) = k1r; *(LAS u32x4*)(d_ + 16384) = v0r; *(LAS u32x4*)(d_ + 16384 + 8192) = v1r; } while (0)
    const int vl = (4 * hi + ((lane & 15) >> 2)) * 64 + ((lane >> 4) & 1) * 32 + (lane & 3) * 8;
    f32x16 o[4]; o[0] = f32x16{}; o[1] = f32x16{}; o[2] = f32x16{}; o[3] = f32x16{};
    float l_run = 0.f;
    const int tfirst = [&] { const float dcut = 150.0f / slope2; const float x = ((float)(q0 - 63) - dcut) * (1.0f / 64.0f); int t0 = (x > 0.f) ? (int)x + 1 : 0; return t0 < nT - 1 ? t0 : nT - 1; }();
    LOAD_T(tfirst); WRITE_T(tfirst & 1); WG_BAR();
    for (int t = tfirst; t < nT; ++t) {
        const int st = t & 1;
        if (t + 1 < nT) LOAD_T(t + 1);
        if (t <= tw) {
            f32x16 p0, p1;
            const LAS unsigned char* kimg = lds + st * 32768 + mp * 8192; const LAS unsigned char* vimg = lds + st * 32768 + 16384;
            qkt_half(p0, kimg, qr, r32, hi, -M0, 0); qkt_half(p1, kimg, qr, r32, hi, -M0, 1);
            const float dq = (float)(qrow - 64 * t - 4 * hi);
            float sum0 = 0.f, sum1 = 0.f;
#pragma unroll
            for (int r = 0; r < 16; ++r) { const float kk = (float)((r & 3) + 8 * (r >> 2)); p0[r] = __builtin_amdgcn_exp2f(p0[r] - slope2 * fabsf(dq - kk)); sum0 += p0[r]; }
            pv_half<4>(o, vimg, vl, p0, 0);
#pragma unroll
            for (int r = 0; r < 16; ++r) { const float kk = (float)((r & 3) + 8 * (r >> 2)); p1[r] = __builtin_amdgcn_exp2f(p1[r] - slope2 * fabsf(dq - kk - 32.0f)); sum1 += p1[r]; }
            pv_half<4>(o, vimg, vl, p1, 1);
            l_run += sum0 + sum1;
        }
        if (t + 1 < nT) WRITE_T(st ^ 1);
        WG_BAR();
    }
    const float lt = l_run + __shfl_xor(l_run, 32), inv = __builtin_amdgcn_rcpf(lt);
    LAS float* X = (LAS float*)lds;
    const int xr = g4 * 32 + r32;
    if (mp == 1) { const float f = inv * lam;
#pragma unroll
        for (int bk = 0; bk < 4; ++bk)
#pragma unroll
            for (int r = 0; r < 16; ++r) X[(bk * 32 + (r & 3) + 8 * (r >> 2) + 4 * hi) * 128 + xr] = o[bk][r] * f; }
    WG_BAR();
    if (mp == 0) { float sq = 0.f;
#pragma unroll
        for (int bk = 0; bk < 4; ++bk)
#pragma unroll
            for (int r = 0; r < 16; ++r) { const float v = o[bk][r] * inv - X[(bk * 32 + (r & 3) + 8 * (r >> 2) + 4 * hi) * 128 + xr]; o[bk][r] = v; sq += v * v; }
        sq += __shfl_xor(sq, 32);
        const float rs = __builtin_amdgcn_rsqf(sq * (1.0f / 128.0f) + 1e-6f);
#pragma unroll
        for (int bk = 0; bk < 4; ++bk)
#pragma unroll
            for (int i = 0; i < 4; ++i) { const f32x4 gv = *(const LAS f32x4*)(prm + 160 + bk * 32 + 8 * i + 4 * hi);
#pragma unroll
                for (int j = 0; j < 4; ++j) o[bk][4 * i + j] *= rs * gv[j]; }
        store_o<4>(A.obase + 1 * BUF + (rowbase + qrow) * PITCH + h * 128, o, hi); }
    WG_BAR();
#undef LOAD_T
#undef WRITE_T
}

__device__ __forceinline__ void attn_phase(const AttnArgs& A, GAS unsigned* counters, LAS unsigned char* lds) {
    LAS unsigned* bc = (LAS unsigned*)(lds + BC_OFF);
    if (threadIdx.x < 64) {
        LAS float* prm = (LAS float*)(lds + PRM_OFF); const int ln = threadIdx.x;
        const GAS float* lq = A.lambda_qk; const float s1 = wave_sum(lq[ln] * lq[64 + ln]), s2 = wave_sum(lq[128 + ln] * lq[192 + ln]);
        const float gb = A.qk_g_diff[ln] * A.qk_g_diff[64 + ln], gc = A.qk_g_ch[ln] * A.qk_g_ch[64 + ln]; float gmb = fabsf(gb), gmc = fabsf(gc);
#pragma unroll
        for (int o_ = 1; o_ < 64; o_ <<= 1) { gmb = fmaxf(gmb, __shfl_xor(gmb, o_)); gmc = fmaxf(gmc, __shfl_xor(gmc, o_)); }
        prm[32 + ln] = gb; prm[96 + ln] = gc; prm[160 + ln] = A.subln_g[ln] * (1.0f - A.lam_init); prm[224 + ln] = A.subln_g[64 + ln] * (1.0f - A.lam_init);
        const float M0c = 8.0f * gmc * LOG2E * 1.02f;
        if (ln == 0) { prm[0] = __expf(s1) - __expf(s2) + A.lam_init; prm[1] = 8.0f * gmb * LOG2E * 1.02f; }
        for (int hc = 0; hc < 8; ++hc) { float bmx = -3.0e38f, bmn = 3.0e38f;
            for (int j = ln; j < 257; j += 64) { const float v = A.rel_bias[hc * 257 + j]; bmx = fmaxf(bmx, v); bmn = fminf(bmn, v); }
#pragma unroll
            for (int o_ = 1; o_ < 64; o_ <<= 1) { bmx = fmaxf(bmx, __shfl_xor(bmx, o_)); bmn = fminf(bmn, __shfl_xor(bmn, o_)); }
            if (ln == 0) { prm[2 + hc] = M0c + bmx * LOG2E; prm[10 + hc] = (2.0f * M0c + (bmx - bmn) * LOG2E < 100.0f) ? 1.0f : 0.0f; } }
    }
    WG_BAR();
    const int x0 = (int)(__builtin_amdgcn_s_getreg((3 << 11) | 20) & 7u);
#pragma unroll 1
    for (int qn = 0; qn < 8; ++qn) {
        const int x = (x0 + qn) & 7; GAS unsigned* counter = counters + 64 * x;
        for (;;) {
            if (threadIdx.x == 0) *bc = __hip_atomic_fetch_add(counter, 1u, __ATOMIC_RELAXED, __HIP_MEMORY_SCOPE_AGENT);
            WG_BAR();
            const int idx = (int)__builtin_amdgcn_readfirstlane(*bc);
            WG_BAR();
            if (idx >= 384) break;
            if (idx < 128) { const int jb = idx >> 4; const int bh = 4 * (2 * x + 1 - (jb >> 2)) + (jb & 3); unit_b(A, bh >> 2, bh & 3, 15 - (idx & 15), lds); }
            else if (idx < 256) { const int jc = idx - 128; const int jh = jc >> 3; const int bh = 8 * (2 * x + 1 - (jh >> 3)) + (jh & 7); const int hc = bh & 7;
                const float shift = ((const LAS float*)(lds + PRM_OFF))[2 + hc]; const bool fixc = __builtin_amdgcn_readfirstlane(__float_as_uint(((const LAS float*)(lds + PRM_OFF))[10 + hc])) != 0u;
                if (fixc) unit_ac<2, true>(A, bh >> 3, hc, 7 - (jc & 7), lds, shift);
                else unit_ac<2, false>(A, bh >> 3, hc, 7 - (jc & 7), lds, 0.f); }
            else { const int ja = idx - 256; const int jp = ja >> 5; const int pr = 2 * (2 * x + 1 - (jp >> 1)) + (jp & 1); unit_a4(A, pr >> 1, pr & 1, 31 - (ja & 31), lds); }
        }
    }
    __builtin_amdgcn_s_setprio(0);
}
#undef LAS
#undef MFMA32
#undef WG_BAR
}
#define LAS __attribute__((address_space(3)))
typedef unsigned short bf16_t;
typedef unsigned v4u __attribute__((ext_vector_type(4)));
typedef float f32x4 __attribute__((ext_vector_type(4)));
constexpr int NWAVES = 8;
constexpr int MT = 32768, DM = 1024, NQKV = 4608, NGATE = 3072, NIN = 7680, DFF = 2816, DEPTH = 4;
constexpr size_t MiB = 1u << 20;
constexpr size_t WS_CTL = 0, CTL_BYTES = 65536;
constexpr size_t WS_ROWSS = 1 * MiB, WS_SS = 3 * MiB;
constexpr size_t WS_WIN = 12 * MiB, WS_WB = 27 * MiB, WS_WOUT = 30 * MiB, WS_WGU = 32 * MiB, WS_WDOWN = 43 * MiB;
constexpr size_t WS_XB = 50 * MiB, WS_QKV = 114 * MiB, WS_G2 = 402 * MiB, WS_MERGED = WS_QKV + 3 * 32 * MiB  , WS_ACT = WS_QKV, WS_END = 466 * MiB;
constexpr int LDS_BYTES = 147456;

__device__ __forceinline__ unsigned f2bf(float f) { unsigned u = __builtin_bit_cast(unsigned, f); return (u + 0x7fffu + ((u >> 16) & 1u)) >> 16; }
__device__ __forceinline__ unsigned pk2(float lo, float hi) { return f2bf(lo) | (f2bf(hi) << 16); }
#define LDS_WAIT() asm volatile("s_waitcnt lgkmcnt(0)" ::: "memory")

template <class RowMap> __device__ __forceinline__ void transpose_item(const GAS float* W, int K, int N, GAS bf16_t* WT, const GAS float* gain, LAS float* scr, int item, int lane, RowMap rm) {
    const int nblk = N / 32, kb = item / nblk, nb = item % nblk, k0 = 64 * kb, n0 = 32 * nb;
    const int kr = lane >> 3, nc = 4 * (lane & 7);
    f32x4 v[8]; float gv[8];
#pragma unroll
    for (int i = 0; i < 8; ++i) { v[i] = *(const GAS f32x4*)(W + (size_t)(k0 + kr + 8 * i) * N + n0 + nc); gv[i] = gain ? gain[k0 + kr + 8 * i] : 1.0f; }
#pragma unroll
    for (int i = 0; i < 8; ++i) { LAS float* d = scr + (kr + 8 * i) * 33 + nc; const f32x4 w = v[i] * gv[i]; d[0] = w[0]; d[1] = w[1]; d[2] = w[2]; d[3] = w[3]; }
    LDS_WAIT(); asm volatile("" ::: "memory");
    const int c = lane & 7;
#pragma unroll
    for (int j = 0; j < 4; ++j) { const int n = (lane >> 3) + 8 * j; const LAS float* s = scr + (8 * c) * 33 + n;
        v4u o; o.x = pk2(s[0 * 33], s[1 * 33]); o.y = pk2(s[2 * 33], s[3 * 33]); o.z = pk2(s[4 * 33], s[5 * 33]); o.w = pk2(s[6 * 33], s[7 * 33]);
        *(GAS v4u*)(WT + (size_t)rm(n0 + n) * K + k0 + 8 * c) = o; }
    LDS_WAIT(); asm volatile("" ::: "memory");
}
struct MapId { int off; __device__ int operator()(int n) const { return off + n; } };
struct MapIn { __device__ int operator()(int n) const { if (n >= 4608) return n; const int s = n >> 9; const int d = (int)((0x872651430ULL >> (4 * s)) & 15ULL); return d * 512 + (n & 511); } };
struct MapGU { __device__ int operator()(int n) const { const int up = n >= 2816 ? 1 : 0; const int c = n - up * 2816; return (c >> 2) * 8 + up * 4 + (c & 3); } };

__device__ __forceinline__ unsigned long long ldptr(volatile LAS unsigned long long* PT, int i) { asm volatile("" : "+v"(PT)); const unsigned long long v = PT[i]; const unsigned lo = __builtin_amdgcn_readfirstlane((unsigned)v), hi = __builtin_amdgcn_readfirstlane((unsigned)(v >> 32)); return ((unsigned long long)hi << 32) | lo; }
#define XB_TMO      128
#define XB_XCNT(j)  (256  + 64 * (j))
#define XB_XSUB(j)  (1280 + 64 * (j))
#define XB_XGEN(j)  (2304 + 64 * (j))
#define XB_TOP      3328
#define XB_TOPGEN   3392
#define XCD_BAR_WORDS 3456
#define XB_SPIN_CAP (1u << 18)

__device__ __forceinline__ unsigned xb_ld(GAS unsigned* p)              { return __hip_atomic_load(p, __ATOMIC_RELAXED, __HIP_MEMORY_SCOPE_AGENT); }
__device__ __forceinline__ unsigned xb_add(GAS unsigned* p, unsigned v) { return __hip_atomic_fetch_add(p, v, __ATOMIC_RELAXED, __HIP_MEMORY_SCOPE_AGENT); }
__device__ __forceinline__ unsigned xb_xcc_id() { return (unsigned)__builtin_amdgcn_s_getreg((3 << 11) | 20) & 0xFu; }
#define XB_SPIN(cond, bar) do { unsigned _sp = 0; while (cond) { __builtin_amdgcn_s_sleep(1); \
    if ((++_sp & 255u) == 0u) { if (xb_ld(&(bar)[XB_TMO])) break; if (_sp > XB_SPIN_CAP) { xb_add(&(bar)[XB_TMO], 1u); break; } } } } while (0)

struct XcdBarrier {
    GAS unsigned* bar; unsigned x;
    volatile LAS unsigned* st;
};

__device__ __forceinline__ XcdBarrier xcd_barrier_post(GAS unsigned* bar, volatile LAS unsigned* st) {
    XcdBarrier b; b.bar = bar; b.x = xb_xcc_id(); b.st = st;
    if (threadIdx.x == 0) (void)xb_add(&bar[XB_XCNT(b.x)], 1u);
    return b;
}
__device__ __forceinline__ void xcd_barrier_complete(GAS unsigned* bar, unsigned x, unsigned& nloc, unsigned& nx) {
    const unsigned G = gridDim.x * gridDim.y * gridDim.z;
    unsigned sum, cnt, mine, sp = 0u;
    for (;;) {
        sum = 0u; cnt = 0u; mine = 0u;
#pragma unroll
        for (unsigned j = 0; j < 16; ++j) { const unsigned c = xb_ld(&bar[XB_XCNT(j)]); sum += c; cnt += (c > 0u) ? 1u : 0u; mine = (j == x) ? c : mine; }
        if (sum == G) break;
        __builtin_amdgcn_s_sleep(1);
        if ((++sp & 255u) == 0u) { if (xb_ld(&bar[XB_TMO])) break; if (sp > XB_SPIN_CAP) { xb_add(&bar[XB_TMO], 1u); break; } }
    }
    nloc = mine > 0u ? mine : 1u; nx = cnt > 0u ? cnt : 1u;
}

__device__ __forceinline__ void xcd_barrier(const XcdBarrier& b) {
    asm volatile("s_waitcnt vmcnt(0)" ::: "memory");
    __syncthreads();
    if (threadIdx.x == 0) {
        GAS unsigned* bar = b.bar;
        __builtin_amdgcn_s_waitcnt(0);
        unsigned nloc = b.st[0], nx = b.st[1];
        if (nloc == 0u) { xcd_barrier_complete(bar, b.x, nloc, nx); b.st[0] = nloc; b.st[1] = nx; }
        const unsigned old = xb_add(&bar[XB_XSUB(b.x)], 1u);
        const unsigned gen = old / nloc;
        if (old + 1u == (gen + 1u) * nloc) {
            __builtin_amdgcn_fence(__ATOMIC_RELEASE, "agent");
            asm volatile("s_waitcnt vmcnt(0)" ::: "memory");
            const unsigned og = xb_add(&bar[XB_TOP], 1u);
            const unsigned tg = og / nx;
            if (og + 1u == (tg + 1u) * nx) xb_add(&bar[XB_TOPGEN], 1u);
            else XB_SPIN(xb_ld(&bar[XB_TOPGEN]) == tg, bar);
            __builtin_amdgcn_fence(__ATOMIC_ACQUIRE, "agent");
            xb_add(&bar[XB_XGEN(b.x)], 1u);
            asm volatile("s_waitcnt vmcnt(0)" ::: "memory");
        } else {
            XB_SPIN(xb_ld(&bar[XB_XGEN(b.x)]) == gen, bar);
            __builtin_amdgcn_fence(__ATOMIC_ACQUIRE, "agent");
            asm volatile("s_waitcnt vmcnt(0)" ::: "memory");
        }
    }
    __syncthreads();
}
struct Args { const GAS float* in[16]; GAS float* out; unsigned char* ws; int ph_lo, ph_hi; };

__global__ void __launch_bounds__(NWAVES * 64, 2) fwd_kernel(Args args) {
    extern __shared__ __attribute__((aligned(16))) unsigned char lds_raw[];
    LAS unsigned char* lds = (LAS unsigned char*)lds_raw;
    cg::grid_group grid = cg::this_grid();
    const int tid = threadIdx.x;
    volatile LAS unsigned long long* PT = (volatile LAS unsigned long long*)(lds + 131072 + 2048);
    { unsigned long long v = (unsigned long long)args.ws;
#pragma unroll
      for (int i = 0; i < 16; ++i) v = (tid == i) ? (unsigned long long)args.in[i] : v;
      v = (tid == 16) ? (unsigned long long)args.out : v;
      if (tid < 18) PT[tid] = v; }
    volatile LAS unsigned* MISC = (volatile LAS unsigned*)(lds + 131072 + 1024);
    if (tid < 2) MISC[tid] = 0u;
    (void)xcd_barrier_post((GAS unsigned*)args.ws + 1024, MISC);
    __syncthreads();
#define PTRF(i) ((const GAS float*)ldptr(PT, (i)))
#define WSP(off) ((GAS unsigned char*)ldptr(PT, 17) + (off))
#define OUTP ((GAS float*)ldptr(PT, 16))
    const int lo = args.ph_lo, hi_ph = args.ph_hi;
#ifndef PHMASK
#define PHMASK 255
#endif
#define REP_G1 1
#define REP_GG 1
#define REP_G2 1
#define REP_G4 1
#define REP_G3 1
#define REP_G5 1
#ifndef REP_ATT
#define REP_ATT 1
#endif
#ifndef REP_P0
#define REP_P0 1
#endif
#ifndef EXTRA_SYNC
#define EXTRA_SYNC 0
#endif
#define IN(k) (((PHMASK >> ((k) & 7)) & 1) && lo <= (k) && (k) < hi_ph)
#define SEAM(k) do { if (IN(k) && IN((k) + 1)) { if ((k) == 0) grid.sync(); else { XcdBarrier xb_; xb_.bar = (GAS unsigned*)WSP(WS_CTL) + 1024; xb_.x = xb_xcc_id(); xb_.st = MISC; xcd_barrier(xb_); } } } while (0)
#pragma unroll 1
    for (int l = 0; l < DEPTH; ++l) {
        const int P = l * 8;
        if (IN(P + 0))
_Pragma("unroll 1")
        for (int rep_ = 0; rep_ < REP_P0; ++rep_) {
            int bid = blockIdx.x, Gl = gridDim.x; asm volatile("" : "+s"(bid), "+s"(Gl));
            int tl = threadIdx.x; asm volatile("" : "+v"(tl)); const int lane = tl & 63, wave = __builtin_amdgcn_readfirstlane(tl >> 6);
            LAS float* scr = (LAS float*)(lds + wave * 16384); const int gw = bid * NWAVES + wave, NGW = Gl * NWAVES;
            const GAS float* w_in = PTRF(2) + (size_t)l * DM * NIN; const GAS float* g_mix = PTRF(1) + (size_t)l * DM;
            const GAS float* w_sb = PTRF(9) + (size_t)l * 512 * DM; const GAS float* w_df = PTRF(10) + (size_t)l * 512 * DM; const GAS float* w_ch = PTRF(11) + (size_t)l * 512 * DM;
            const GAS float* w_out = PTRF(12) + (size_t)l * DM * DM; const GAS float* g_ffn = PTRF(13) + (size_t)l * DM;
            const GAS float* w_gu = PTRF(14) + (size_t)l * DM * 2 * DFF; const GAS float* w_down = PTRF(15) + (size_t)l * DFF * DM;
            constexpr int I_IN = (DM / 64) * (NIN / 32), I_B = (512 / 64) * (DM / 32), I_O = (DM / 64) * (DM / 32), I_GU = (DM / 64) * (2 * DFF / 32), I_DN = (DFF / 64) * (DM / 32);
            constexpr int NITEMS = I_IN + 3 * I_B + I_O + I_GU + I_DN;
            for (int it = gw; it < NITEMS; it += NGW) {
                int r = it;
                if (r < I_IN) { transpose_item(w_in, DM, NIN, ((GAS bf16_t*)WSP(WS_WIN)), g_mix, scr, r, lane, MapIn{}); continue; } r -= I_IN;
                if (r < I_B) { transpose_item(w_sb, 512, DM, ((GAS bf16_t*)WSP(WS_WB)), nullptr, scr, r, lane, MapId{0}); continue; } r -= I_B;
                if (r < I_B) { transpose_item(w_df, 512, DM, ((GAS bf16_t*)WSP(WS_WB)), nullptr, scr, r, lane, MapId{1024}); continue; } r -= I_B;
                if (r < I_B) { transpose_item(w_ch, 512, DM, ((GAS bf16_t*)WSP(WS_WB)), nullptr, scr, r, lane, MapId{2048}); continue; } r -= I_B;
                if (r < I_O) { transpose_item(w_out, DM, DM, ((GAS bf16_t*)WSP(WS_WOUT)), nullptr, scr, r, lane, MapId{0}); continue; } r -= I_O;
                if (r < I_GU) { transpose_item(w_gu, DM, 2 * DFF, ((GAS bf16_t*)WSP(WS_WGU)), g_ffn, scr, r, lane, MapGU{}); continue; } r -= I_GU;
                transpose_item(w_down, DFF, DM, ((GAS bf16_t*)WSP(WS_WDOWN)), nullptr, scr, r, lane, MapId{0});
            }
            if (l == 0) {
                for (int m = gw; m < MT; m += NGW) { const GAS f32x4* xr = (const GAS f32x4*)(PTRF(0) + (size_t)m * DM) + lane; f32x4 v[4]; float s = 0.f;
#pragma unroll
                    for (int j = 0; j < 4; ++j) { v[j] = xr[64 * j]; s += (v[j][0] * v[j][0] + v[j][1] * v[j][1]) + (v[j][2] * v[j][2] + v[j][3] * v[j][3]); }
                    s = att::wave_sum(s);
                    GAS unsigned long long* o8 = (GAS unsigned long long*)(((GAS bf16_t*)WSP(WS_XB)) + (size_t)m * DM) + lane;
#pragma unroll
                    for (int j = 0; j < 4; ++j) o8[64 * j] = (unsigned long long)pk2(v[j][0], v[j][1]) | ((unsigned long long)pk2(v[j][2], v[j][3]) << 32);
                    if (lane < 16) ((GAS float*)WSP(WS_ROWSS))[(size_t)m * 16 + lane] = (lane == 0) ? s : 0.f; }
            }
        }
        SEAM(P + 0);
        for (int xs_ = 0; xs_ < EXTRA_SYNC; ++xs_) grid.sync();
        if (IN(P + 1))
_Pragma("unroll 1")
        for (int rep_ = 0; rep_ < REP_G1; ++rep_) {
            int bid = blockIdx.x, Gl = gridDim.x; asm volatile("" : "+s"(bid), "+s"(Gl));
            pg8::Gemm g{((GAS bf16_t*)WSP(WS_XB)), ((GAS bf16_t*)WSP(WS_WIN)), MT, NIN, DM}; pg8::StaticOrder S; S.init(MT, NIN, Gl, bid);
            pg8::EpiQKVG E{pg8::EpiQKV{((GAS bf16_t*)WSP(WS_QKV)), ((GAS float*)WSP(WS_ROWSS)), ((GAS float*)WSP(WS_SS))}, (GAS bf16_t*)OUTP, (GAS bf16_t*)WSP(WS_G2), PTRF(3) + (size_t)l * NGATE};
            pg8::gemm_phase<pg8::EpiQKVG, pg8::StaticOrder, true, true>(lds, g, S, E);
        }
        SEAM(P + 1);
        if (IN(P + 2))
_Pragma("unroll 1")
        for (int rep_ = 0; rep_ < REP_ATT; ++rep_) {
            int bid = blockIdx.x, Gl = gridDim.x; asm volatile("" : "+s"(bid), "+s"(Gl));
            att::AttnArgs A{((GAS bf16_t*)WSP(WS_QKV)), ((GAS bf16_t*)WSP(rep_ + 1 < REP_ATT ? WS_MERGED : WS_QKV)), ((GAS float*)WSP(WS_SS)), PTRF(4) + (size_t)l * 128, PTRF(5) + (size_t)l * 256, PTRF(6) + (size_t)l * 128, PTRF(7) + (size_t)l * 128, PTRF(8) + (size_t)l * 8 * 257, 0.8f - 0.6f * __expf(-0.3f * (float)l)};
            att::attn_phase(A, ((GAS unsigned*)WSP(WS_CTL)) + 8192 + 512 * (l + 4 * rep_), lds);
            if (rep_ + 1 < REP_ATT) grid.sync();
        }
        SEAM(P + 2);
        if (IN(P + 4))
_Pragma("unroll 1")
        for (int rep_ = 0; rep_ < REP_G2; ++rep_) {
            int bid = blockIdx.x, Gl = gridDim.x; asm volatile("" : "+s"(bid), "+s"(Gl));
            pg8::Gemm g{((GAS bf16_t*)WSP(WS_QKV)), ((GAS bf16_t*)WSP(WS_WB)), 3 * MT, 3 * DM, 512}; const int vcu = (Gl % 8 == 0) ? (bid % 8) * (Gl / 8) + bid / 8 : bid; pg8::BranchOrder S{Gl, vcu};
            pg8::EpiBranch E{(const GAS bf16_t*)OUTP, (const GAS bf16_t*)WSP(WS_G2), ((GAS bf16_t*)WSP(WS_MERGED))};
            pg8::gemm_phase<pg8::EpiBranch, pg8::BranchOrder, true, true>(lds, g, S, E);
        }
        SEAM(P + 4);
        if (IN(P + 5))
_Pragma("unroll 1")
        for (int rep_ = 0; rep_ < REP_G3; ++rep_) {
            int bid = blockIdx.x, Gl = gridDim.x; asm volatile("" : "+s"(bid), "+s"(Gl));
            pg8::Gemm g{((GAS bf16_t*)WSP(WS_MERGED)), ((GAS bf16_t*)WSP(WS_WOUT)), MT, DM, DM}; pg8::StaticOrder S; S.init(MT, DM, Gl, bid);
            pg8::EpiResid E{(GAS float*)nullptr, ((GAS bf16_t*)WSP(WS_XB)), ((GAS float*)WSP(WS_ROWSS))};
            pg8::gemm_phase<pg8::EpiResid, pg8::StaticOrder, true, true>(lds, g, S, E);
        }
        SEAM(P + 5);
        if (IN(P + 6))
_Pragma("unroll 1")
        for (int rep_ = 0; rep_ < REP_G4; ++rep_) {
            int bid = blockIdx.x, Gl = gridDim.x; asm volatile("" : "+s"(bid), "+s"(Gl));
            pg8::Gemm g{((GAS bf16_t*)WSP(WS_XB)), ((GAS bf16_t*)WSP(WS_WGU)), MT, 2 * DFF, DM}; pg8::StaticOrder S; S.init(MT, 2 * DFF, Gl, bid);
            pg8::EpiSwiGLU E{((GAS bf16_t*)WSP(WS_ACT)), ((GAS float*)WSP(WS_ROWSS))};
            pg8::gemm_phase<pg8::EpiSwiGLU, pg8::StaticOrder, true, true>(lds, g, S, E);
        }
        SEAM(P + 6);
        if (IN(P + 7))
_Pragma("unroll 1")
        for (int rep_ = 0; rep_ < REP_G5; ++rep_) {
            int bid = blockIdx.x, Gl = gridDim.x; asm volatile("" : "+s"(bid), "+s"(Gl));
            pg8::Gemm g{((GAS bf16_t*)WSP(WS_ACT)), ((GAS bf16_t*)WSP(WS_WDOWN)), MT, DM, DFF}; pg8::StaticOrder S; S.init(MT, DM, Gl, bid);
            pg8::EpiResid E{(l == DEPTH - 1) ? OUTP : (GAS float*)nullptr, ((GAS bf16_t*)WSP(WS_XB)), ((GAS float*)WSP(WS_ROWSS))};
            pg8::gemm_phase<pg8::EpiResid, pg8::StaticOrder, true, true>(lds, g, S, E);
        }
        SEAM(P + 7);
    }
#undef IN
#undef SEAM
}

#ifndef MK_SPLIT
#define MK_SPLIT 0
#endif
extern "C" void kernel_launch(void* const* d_in, const int* in_sizes, int n_in, void* d_out, int out_size, void* d_ws, size_t ws_size, hipStream_t stream) {
    static int grid = 0;
    if (grid == 0) {
        if (n_in != 16 || in_sizes[0] != MT * DM || out_size != MT * DM || ws_size < WS_END) { fprintf(stderr, "kernel_launch: unexpected shapes / workspace (n_in %d, ws %zu); nothing launched\n", n_in, ws_size); grid = -1; return; }
        int dev = 0, cus = 0, per_cu = 0;
        if (hipGetDevice(&dev) != hipSuccess || hipDeviceGetAttribute(&cus, hipDeviceAttributeMultiprocessorCount, dev) != hipSuccess) { grid = -1; return; }
        if (hipFuncSetAttribute((const void*)fwd_kernel, hipFuncAttributeMaxDynamicSharedMemorySize, LDS_BYTES) != hipSuccess) { fprintf(stderr, "kernel_launch: hipFuncSetAttribute failed\n"); grid = -1; return; }
        if (hipOccupancyMaxActiveBlocksPerMultiprocessor(&per_cu, (const void*)fwd_kernel, NWAVES * 64, LDS_BYTES) != hipSuccess || per_cu < 1) { fprintf(stderr, "kernel_launch: occupancy query says %d blocks per CU\n", per_cu); per_cu = 1; }
        (void)hipGetLastError();
        grid = cus;
    }
    if (grid < 0) return;
    (void)hipMemsetAsync((char*)d_ws + WS_CTL, 0, CTL_BYTES, stream);
    Args a{};
    for (int i = 0; i < 16; ++i) a.in[i] = (const GAS float*)d_in[i];
    a.out = (GAS float*)d_out; a.ws = (unsigned char*)d_ws;
#if MK_SPLIT
    for (int p = 0; p < 8 * DEPTH; ++p) { a.ph_lo = p; a.ph_hi = p + 1; hipLaunchKernelGGL(fwd_kernel, dim3(grid), dim3(NWAVES * 64), LDS_BYTES, stream, a); }
#else
    a.ph_lo = 0; a.ph_hi = 8 * DEPTH;
    void* kargs[] = {&a};
    hipError_t e = hipLaunchCooperativeKernel((const void*)fwd_kernel, dim3(grid), dim3(NWAVES * 64), kargs, LDS_BYTES, stream);
    if (e != hipSuccess) fprintf(stderr, "kernel_launch: cooperative launch failed: %s (grid %d)\n", hipGetErrorString(e), grid);
#endif
}
```

```cpp
#include <hip/hip_runtime.h>
#include <hip/hip_cooperative_groups.h>
#include <cstdio>
#include <cstdint>
namespace cg = cooperative_groups;
#define GAS __attribute__((address_space(1)))
namespace pg8 {
#define PG8_LAS __attribute__((address_space(3)))
typedef unsigned short bf16_t;
typedef short bf16x8 __attribute__((ext_vector_type(8)));
typedef float f32x4 __attribute__((ext_vector_type(4)));
typedef unsigned u32x4 __attribute__((ext_vector_type(4)));
constexpr int BM = 256, BK = 64, HALF = 128, HTB = HALF * BK * 2  , STAGE_BYTES = 8 * HTB, NXCD = 8, WGM = 4;

__host__ __device__ __forceinline__ int lds_byte(int r, int c) { const int st = (r >> 4) * 2 + (c >> 5), rr = r & 15, cc = c & 31, ob = rr * 64 + cc * 2; return st * 1024 + (ob ^ (((ob >> 9) & 1) << 5)); }
__host__ __device__ __forceinline__ void stage_rc(int b, int& R, int& C) { const int st = b / 1024, sb = b % 1024, swz = sb ^ (((sb >> 9) & 1) << 5); R = (st >> 1) * 16 + swz / 64; C = (st & 1) * 32 + (swz % 64) / 2; }
__host__ __device__ __forceinline__ int perm32(int rho) { const int n = rho >> 4, i = rho & 15; return 8 * (i >> 2) + 4 * n + (i & 3); }

struct Unit { int pm, pn; };
struct Gemm { const __attribute__((address_space(1))) bf16_t* A; const __attribute__((address_space(1))) bf16_t* Bt; int M, N, K; };

struct StaticOrder {
    int nM, nN, nwg, G, c;
    __host__ __device__ void init(int M, int N, int G_, int c_) { nM = M / BM; nN = N / BM; nwg = nM * nN; G = G_; c = c_; }
    __host__ __device__ bool next(int i, Unit& u) const {
        const long L = (long)i * G + c; if (L >= nwg) return false;
        int wgid = (int)L; { const int q = nwg / NXCD, r = nwg % NXCD, xcd = wgid % NXCD, off = wgid / NXCD; wgid = (xcd < r ? xcd * (q + 1) : r * (q + 1) + (xcd - r) * q) + off; }
        const int nig = WGM * nN, gid = wgid / nig, fm = gid * WGM, gsz = (nM - fm) < WGM ? (nM - fm) : WGM;
        u.pm = fm + ((wgid % nig) % gsz); u.pn = (wgid % nig) / gsz; return true;
    }
    __device__ __forceinline__ void a_ready(const Unit&) const {}
    __device__ __forceinline__ void done(const Unit&) const {}
};

typedef float f32x2 __attribute__((ext_vector_type(2)));
typedef __bf16 bf16x2_t __attribute__((ext_vector_type(2)));
typedef unsigned u32x2 __attribute__((ext_vector_type(2)));
__device__ __forceinline__ unsigned cvt_pk_bf16(float lo, float hi) { f32x2 v = {lo, hi}; bf16x2_t b = __builtin_convertvector(v, bf16x2_t); return __builtin_bit_cast(unsigned, b); }
__device__ __forceinline__ float bf_lo(unsigned u) { return __uint_as_float(u << 16); }
__device__ __forceinline__ float bf_hi(unsigned u) { return __uint_as_float(u & 0xffff0000u); }
constexpr int MROWS = 32768;
constexpr float LOG2E = 1.4426950408889634f;
__device__ __forceinline__ float sigmoid_f(float x) { return __builtin_amdgcn_rcpf(1.0f + __builtin_amdgcn_exp2f(-x * LOG2E)); }
__device__ __forceinline__ float row_rs(const GAS float* rowss, int row) {
    const GAS f32x4* p = (const GAS f32x4*)(rowss + (size_t)row * 16); const f32x4 a = p[0], b = p[1], c = p[2], d = p[3];
    const float s = ((a[0] + a[1]) + (a[2] + a[3])) + ((b[0] + b[1]) + (b[2] + b[3])) + ((c[0] + c[1]) + (c[2] + c[3])) + ((d[0] + d[1]) + (d[2] + d[3]));
    return __builtin_amdgcn_rsqf(s * (1.0f / 1024.0f) + 1e-6f);
}
struct EpiQKV {
    static constexpr bool PERM = true, AFTER_DRAIN = false, CHAIN = false;
    GAS bf16_t* QKV; const GAS float* rowss; GAS float* ss; const GAS float* rs1;
    __device__ __forceinline__ void operator()(const f32x4 (&acc)[2][2][4][2], const Unit& u, int wr, int wc, int fr, int fq) const {
        const int row0 = u.pm * BM + wr * 64 + fr; const int t = u.pn >> 1, colt = (u.pn & 1) * 256;
        GAS bf16_t* base = QKV + (size_t)t * MROWS * 512; const int col0 = colt + wc * 32 + 8 * fq;
        const int sidx = (t == 1) ? 0 : (t == 2) ? 1 : (t == 5) ? 2 : (t == 7) ? 3 : -1;
#pragma unroll
        for (int ai = 0; ai < 2; ++ai)
#pragma unroll
            for (int m = 0; m < 4; ++m) { const int row = row0 + ai * HALF + m * 16; const float rs = rs1[row]; GAS bf16_t* rowp = base + (size_t)row * 512 + col0;
#pragma unroll
                for (int bj = 0; bj < 2; ++bj) { const f32x4 v0 = acc[ai][bj][m][0] * rs, v1 = acc[ai][bj][m][1] * rs;
                    u32x4 w; w.x = cvt_pk_bf16(v0[0], v0[1]); w.y = cvt_pk_bf16(v0[2], v0[3]); w.z = cvt_pk_bf16(v1[0], v1[1]); w.w = cvt_pk_bf16(v1[2], v1[3]);
                    *(GAS u32x4*)(rowp + bj * HALF) = w;
                    if (sidx >= 0) { float q = ((v0[0] * v0[0] + v0[1] * v0[1]) + (v0[2] * v0[2] + v0[3] * v0[3])) + ((v1[0] * v1[0] + v1[1] * v1[1]) + (v1[2] * v1[2] + v1[3] * v1[3]));
                        q += __shfl_xor(q, 16); q += __shfl_xor(q, 32);
                        if (fq == 0) ss[((size_t)sidx * MROWS + row) * 16 + (colt >> 5) + 4 * bj + wc] = q; } } }
    }
};
struct EpiQKVG {
    static constexpr bool PERM = true, AFTER_DRAIN = false, CHAIN = false;
    EpiQKV q; GAS bf16_t* g01; GAS bf16_t* g2; const GAS float* bias;
    __device__ __forceinline__ void operator()(const f32x4 (&acc)[2][2][4][2], const Unit& u, int wr, int wc, int fr, int fq) const {
        if (u.pn < 18) { q(acc, u, wr, wc, fr, fq); return; }
        const int c = u.pn - 18, br = c >> 2; GAS bf16_t* G = (br < 2) ? g01 + (size_t)br * MROWS * 1024 : g2;
        const int row0 = u.pm * BM + wr * 64 + fr; const int col0 = (c & 3) * BM + wc * 32 + 8 * fq;
        f32x4 bv[2][2];
#pragma unroll
        for (int bj = 0; bj < 2; ++bj)
#pragma unroll
            for (int n = 0; n < 2; ++n) bv[bj][n] = *(const GAS f32x4*)(bias + br * 1024 + col0 + bj * HALF + 4 * n);
#pragma unroll
        for (int ai = 0; ai < 2; ++ai)
#pragma unroll
            for (int m = 0; m < 4; ++m) { const int row = row0 + ai * HALF + m * 16; const float rs = q.rs1[row]; GAS bf16_t* rowp = G + (size_t)row * 1024 + col0;
#pragma unroll
                for (int bj = 0; bj < 2; ++bj) { const f32x4 v0 = acc[ai][bj][m][0] * rs + bv[bj][0], v1 = acc[ai][bj][m][1] * rs + bv[bj][1];
                    u32x4 w; w.x = cvt_pk_bf16(fmaxf(sigmoid_f(v0[0]), 1e-30f), fmaxf(sigmoid_f(v0[1]), 1e-30f)); w.y = cvt_pk_bf16(fmaxf(sigmoid_f(v0[2]), 1e-30f), fmaxf(sigmoid_f(v0[3]), 1e-30f));
                    w.z = cvt_pk_bf16(fmaxf(sigmoid_f(v1[0]), 1e-30f), fmaxf(sigmoid_f(v1[1]), 1e-30f)); w.w = cvt_pk_bf16(fmaxf(sigmoid_f(v1[2]), 1e-30f), fmaxf(sigmoid_f(v1[3]), 1e-30f));
                    *(GAS u32x4*)(rowp + bj * HALF) = w; } }
    }
};
struct EpiBranch {
    static constexpr bool PERM = true, AFTER_DRAIN = false, CHAIN = true;
    const GAS bf16_t* g01; const GAS bf16_t* g2; GAS bf16_t* Mg;
    __device__ __forceinline__ bool keep(const Unit& u) const { return (u.pm >> 7) < 2; }
    __device__ __forceinline__ void operator()(f32x4 (&acc)[2][2][4][2], const Unit& u, int wr, int wc, int fr, int fq) const {
        const int br = u.pm >> 7, pm = u.pm & 127, pn = u.pn & 3;
        const int row0 = pm * BM + wr * 64 + fr; const int col0 = pn * BM + wc * 32 + 8 * fq;
#pragma unroll
        for (int ai = 0; ai < 2; ++ai)
#pragma unroll
            for (int m = 0; m < 4; ++m) { const int row = row0 + ai * HALF + m * 16; const GAS bf16_t* gp = ((br < 2) ? g01 + (size_t)br * MROWS * 1024 : g2) + (size_t)row * 1024 + col0; const GAS bf16_t* gn = ((br == 0) ? g01 + (size_t)MROWS * 1024 : g2) + (size_t)row * 1024 + col0; GAS bf16_t* mp = Mg + (size_t)row * 1024 + col0;
#pragma unroll
                for (int bj = 0; bj < 2; ++bj) { const u32x4 g = *(const GAS u32x4*)(gp + bj * HALF);
                    f32x4 s0 = {bf_lo(g.x), bf_hi(g.x), bf_lo(g.y), bf_hi(g.y)}, s1 = {bf_lo(g.z), bf_hi(g.z), bf_lo(g.w), bf_hi(g.w)};
                    if (br < 2) { const u32x4 h = *(const GAS u32x4*)(gn + bj * HALF);
                        const f32x4 d0 = {bf_lo(h.x), bf_hi(h.x), bf_lo(h.y), bf_hi(h.y)}, d1 = {bf_lo(h.z), bf_hi(h.z), bf_lo(h.w), bf_hi(h.w)};
#pragma unroll
                        for (int e = 0; e < 4; ++e) { s0[e] *= __builtin_amdgcn_rcpf(fmaxf(d0[e], 1e-30f)); s1[e] *= __builtin_amdgcn_rcpf(fmaxf(d1[e], 1e-30f)); }
                        acc[ai][bj][m][0] *= s0; acc[ai][bj][m][1] *= s1;
                    } else { const f32x4 v0 = acc[ai][bj][m][0] * s0, v1 = acc[ai][bj][m][1] * s1;
                        u32x4 w; w.x = cvt_pk_bf16(v0[0], v0[1]); w.y = cvt_pk_bf16(v0[2], v0[3]); w.z = cvt_pk_bf16(v1[0], v1[1]); w.w = cvt_pk_bf16(v1[2], v1[3]);
                        *(GAS u32x4*)(mp + bj * HALF) = w; } } }
    }
};
struct GateOrder {
    int G, c;
    __device__ bool next(int i, Unit& u) const { const int j = i / 3, br = i - 3 * j; const int pmn = c + j * G; if (pmn >= 512) return false; u.pm = pmn >> 2; u.pn = br * 4 + (pmn & 3); return true; }
    __device__ __forceinline__ void a_ready(const Unit&) const {}
    __device__ __forceinline__ void done(const Unit&) const {}
};
struct BranchOrder {
    int G, c;
    __device__ bool next(int i, Unit& u) const { const int j = i / 3, br = i - 3 * j; const int pmn = c + j * G; if (pmn >= 512) return false; u.pm = br * 128 + (pmn >> 2); u.pn = br * 4 + (pmn & 3); return true; }
    __device__ __forceinline__ void a_ready(const Unit&) const {}
    __device__ __forceinline__ void done(const Unit&) const {}
};
struct EpiResid {
    static constexpr bool PERM = true, AFTER_DRAIN = false, CHAIN = false;
    GAS float* out; GAS bf16_t* xb; GAS float* rowss;
    __device__ __forceinline__ void operator()(const f32x4 (&acc)[2][2][4][2], const Unit& u, int wr, int wc, int fr, int fq) const {
        const int row0 = u.pm * BM + wr * 64 + fr; const int col0 = u.pn * BM + wc * 32 + 8 * fq;
#pragma unroll
        for (int ai = 0; ai < 2; ++ai)
#pragma unroll
            for (int m = 0; m < 4; ++m) { const int row = row0 + ai * HALF + m * 16; const size_t off = (size_t)row * 1024 + col0; float q = 0.f;
#pragma unroll
                for (int bj = 0; bj < 2; ++bj) { const u32x4 xo = *(const GAS u32x4*)(xb + off + bj * HALF);
                    f32x4 v0 = acc[ai][bj][m][0], v1 = acc[ai][bj][m][1];
                    v0[0] += bf_lo(xo.x); v0[1] += bf_hi(xo.x); v0[2] += bf_lo(xo.y); v0[3] += bf_hi(xo.y); v1[0] += bf_lo(xo.z); v1[1] += bf_hi(xo.z); v1[2] += bf_lo(xo.w); v1[3] += bf_hi(xo.w);
                    if (out) { *(GAS f32x4*)(out + off + bj * HALF) = v0; *(GAS f32x4*)(out + off + bj * HALF + 4) = v1; }
                    u32x4 w; w.x = cvt_pk_bf16(v0[0], v0[1]); w.y = cvt_pk_bf16(v0[2], v0[3]); w.z = cvt_pk_bf16(v1[0], v1[1]); w.w = cvt_pk_bf16(v1[2], v1[3]);
                    *(GAS u32x4*)(xb + off + bj * HALF) = w;
                    q += ((v0[0] * v0[0] + v0[1] * v0[1]) + (v0[2] * v0[2] + v0[3] * v0[3])) + ((v1[0] * v1[0] + v1[1] * v1[1]) + (v1[2] * v1[2] + v1[3] * v1[3])); }
                q += __shfl_xor(q, 16); q += __shfl_xor(q, 32);
                if (fq == 0) rowss[(size_t)row * 16 + u.pn * 4 + wc] = q; }
    }
};
struct EpiSwiGLU {
    static constexpr bool PERM = true, AFTER_DRAIN = false, CHAIN = false;
    GAS bf16_t* H; const GAS float* rowss;
    __device__ __forceinline__ void operator()(const f32x4 (&acc)[2][2][4][2], const Unit& u, int wr, int wc, int fr, int fq) const {
        const int row0 = u.pm * BM + wr * 64 + fr; const int col0 = (u.pn * BM + wc * 32 + 8 * fq) >> 1;
#pragma unroll
        for (int ai = 0; ai < 2; ++ai)
#pragma unroll
            for (int m = 0; m < 4; ++m) { const int row = row0 + ai * HALF + m * 16; const float rs = row_rs(rowss, row); GAS bf16_t* rowp = H + (size_t)row * 2816 + col0;
#pragma unroll
                for (int bj = 0; bj < 2; ++bj) { const f32x4 g = acc[ai][bj][m][0] * rs, uu = acc[ai][bj][m][1] * rs;
                    u32x2 w; w.x = cvt_pk_bf16(g[0] * sigmoid_f(g[0]) * uu[0], g[1] * sigmoid_f(g[1]) * uu[1]); w.y = cvt_pk_bf16(g[2] * sigmoid_f(g[2]) * uu[2], g[3] * sigmoid_f(g[3]) * uu[3]);
                    *(GAS u32x2*)(rowp + bj * (HALF / 2)) = w; } }
    }
};

template <class Epi, class Sched, bool ALIGN_EPI = false, bool SP2 = false>
__device__ __forceinline__ void gemm_phase(PG8_LAS unsigned char* lds, const Gemm g, const Sched& S, const Epi& E) {
    int tid_ = threadIdx.x; asm volatile("" : "+v"(tid_));
    const int tid = tid_, wid = __builtin_amdgcn_readfirstlane(tid >> 6), lane = tid & 63, wr = wid >> 2, wc = wid & 3, fr = lane & 15, fq = lane >> 4;
    const int K = g.K, nt = K / BK;
    unsigned voffA[2], voffB[2];
#pragma unroll
    for (int i = 0; i < 2; ++i) { int R, C; stage_rc(tid * 16 + i * 8192, R, C); const int Rb = Epi::PERM ? ((R & ~31) + perm32(R & 31)) : R;
        voffA[i] = (unsigned)(R * K + C) * 2u; voffB[i] = (unsigned)(Rb * K + C) * 2u; }
    const size_t kstep = (size_t)(BK * 2);
    const size_t hstep = (size_t)HALF * K * 2;
    const size_t tstep = 2 * hstep;
    const unsigned ldsw = (unsigned)wid * 1024u;
    const int aoff = lds_byte(wr * 64 + fr, fq * 8), boff = lds_byte(wc * 32 + fr, fq * 8);
#define PG8_SA(b, h) (((b) * 2 + (h)) * HTB)
#define PG8_SB(b, h) ((4 + (b) * 2 + (h)) * HTB)
#define PG8_STAGE(bufoff, gbase, voff) do { _Pragma("unroll") for (int _i = 0; _i < 2; ++_i) \
        __builtin_amdgcn_global_load_lds((const unsigned*)((const char*)(gbase) + (voff)[_i]), (PG8_LAS unsigned*)(lds + (bufoff) + ldsw + _i * 8192), 16, 0, 0); } while (0)
#define PG8_LDA(dst, b, h) do { _Pragma("unroll") for (int m = 0; m < 4; ++m) _Pragma("unroll") for (int k = 0; k < 2; ++k) dst[m][k] = *(const PG8_LAS bf16x8*)(lds + PG8_SA(b, h) + aoff + m * 2048 + k * 1024); } while (0)
#define PG8_LDB(dst, b, h) do { _Pragma("unroll") for (int n = 0; n < 2; ++n) _Pragma("unroll") for (int k = 0; k < 2; ++k) dst[n][k] = *(const PG8_LAS bf16x8*)(lds + PG8_SB(b, h) + boff + n * 2048 + k * 1024); } while (0)
#define PG8_MMA(ai, bj, At, Bt) do { __builtin_amdgcn_s_setprio(1); _Pragma("unroll") for (int m = 0; m < 4; ++m) _Pragma("unroll") for (int n = 0; n < 2; ++n) _Pragma("unroll") for (int k = 0; k < 2; ++k) \
        acc[ai][bj][m][n] = __builtin_amdgcn_mfma_f32_16x16x32_bf16(Bt[n][k], At[m][k], acc[ai][bj][m][n], 0, 0, 0); __builtin_amdgcn_s_setprio(0); } while (0)
#define PG8_WAIT_V(n) asm volatile("s_waitcnt vmcnt(" #n ")" ::: "memory")
#define PG8_WAIT_L(n) asm volatile("s_waitcnt lgkmcnt(" #n ")" ::: "memory")
#define PG8_BAR __builtin_amdgcn_s_barrier()
#define PG8_SCHED __builtin_amdgcn_sched_barrier(0)
    Unit cur, nxt; int ui = 0;
    if (!S.next(0, cur)) return;
    f32x4 acc[2][2][4][2];
#pragma unroll
    for (int a = 0; a < 2; ++a)
#pragma unroll
        for (int b = 0; b < 2; ++b)
#pragma unroll
            for (int m = 0; m < 4; ++m)
#pragma unroll
                for (int n = 0; n < 2; ++n) acc[a][b][m][n] = (f32x4){0.f, 0.f, 0.f, 0.f};
    bf16x8 At[4][2], B0[2][2], B1[2][2];
    const char* cA = (const char*)g.A + (size_t)cur.pm * tstep; const char* cB = (const char*)g.Bt + (size_t)cur.pn * tstep;
    S.a_ready(cur);
    if constexpr (SP2) {
        PG8_STAGE(PG8_SB(0, 0), cB, voffB); PG8_STAGE(PG8_SB(0, 1), cB + hstep, voffB); PG8_STAGE(PG8_SA(0, 0), cA, voffA); PG8_STAGE(PG8_SA(0, 1), cA + hstep, voffA);
        if (wr == 1) PG8_BAR;
        PG8_WAIT_V(2); PG8_BAR;
        PG8_STAGE(PG8_SB(1, 0), cB + kstep, voffB); PG8_STAGE(PG8_SA(1, 0), cA + kstep, voffA); PG8_STAGE(PG8_SB(1, 1), cB + hstep + kstep, voffB);
        PG8_WAIT_V(6); PG8_BAR;
    } else {
        PG8_STAGE(PG8_SB(0, 0), cB, voffB); PG8_STAGE(PG8_SA(0, 0), cA, voffA); PG8_STAGE(PG8_SB(0, 1), cB + hstep, voffB); PG8_STAGE(PG8_SA(0, 1), cA + hstep, voffA);
        if (wr == 1) PG8_BAR;
        PG8_WAIT_V(4); PG8_BAR;
        PG8_STAGE(PG8_SB(1, 0), cB + kstep, voffB); PG8_STAGE(PG8_SA(1, 0), cA + kstep, voffA); PG8_STAGE(PG8_SB(1, 1), cB + hstep + kstep, voffB);
        PG8_WAIT_V(6); PG8_BAR;
    }
    for (;;) {
        const bool has_next = S.next(ui + 1, nxt);
        const char* nA = has_next ? (const char*)g.A + (size_t)nxt.pm * tstep : cA; const char* nB = has_next ? (const char*)g.Bt + (size_t)nxt.pn * tstep : cB;
        for (int t = 0; t < nt; t += 2) {
            const bool last = (t == nt - 2);
            const char* a1 = cA + (size_t)(t + 1) * kstep;
            const char* a2 = last ? nA : cA + (size_t)(t + 2) * kstep; const char* b2 = last ? nB : cB + (size_t)(t + 2) * kstep;
            const char* a3 = a2 + kstep; const char* b3 = b2 + kstep;
            if (last && has_next) S.a_ready(nxt);
            if constexpr (SP2) {
            PG8_LDB(B0, 0, 0); PG8_LDB(B1, 0, 1); PG8_SCHED; PG8_LDA(At, 0, 0); PG8_STAGE(PG8_SA(1, 1), a1 + hstep, voffA);
            PG8_WAIT_V(8); PG8_WAIT_L(0); PG8_BAR; PG8_MMA(0, 0, At, B0); PG8_MMA(0, 1, At, B1); PG8_BAR; PG8_SCHED;
            PG8_LDA(At, 0, 1); PG8_STAGE(PG8_SB(0, 0), b2, voffB); PG8_STAGE(PG8_SB(0, 1), b2 + hstep, voffB); PG8_STAGE(PG8_SA(0, 0), a2, voffA);
            PG8_WAIT_V(8); PG8_WAIT_L(0); PG8_BAR; PG8_MMA(1, 0, At, B0); PG8_MMA(1, 1, At, B1); PG8_BAR; PG8_SCHED;
            PG8_LDB(B0, 1, 0); PG8_LDB(B1, 1, 1); PG8_SCHED; PG8_LDA(At, 1, 0); PG8_STAGE(PG8_SA(0, 1), a2 + hstep, voffA);
            PG8_WAIT_V(8); PG8_WAIT_L(0); PG8_BAR; PG8_MMA(0, 0, At, B0); PG8_MMA(0, 1, At, B1); PG8_BAR; PG8_SCHED;
            PG8_LDA(At, 1, 1); PG8_STAGE(PG8_SB(1, 0), b3, voffB); PG8_STAGE(PG8_SB(1, 1), b3 + hstep, voffB); PG8_STAGE(PG8_SA(1, 0), a3, voffA);
            PG8_WAIT_V(8); PG8_WAIT_L(0); PG8_BAR; PG8_MMA(1, 0, At, B0); PG8_MMA(1, 1, At, B1); PG8_BAR; PG8_SCHED;
            } else {
            PG8_LDB(B0, 0, 0); PG8_SCHED; PG8_LDA(At, 0, 0); PG8_STAGE(PG8_SA(1, 1), a1 + hstep, voffA);
            PG8_WAIT_L(8); PG8_BAR; PG8_WAIT_L(0); PG8_MMA(0, 0, At, B0); PG8_BAR; PG8_SCHED;
            PG8_LDB(B1, 0, 1); PG8_STAGE(PG8_SB(0, 0), b2, voffB);
            PG8_BAR; PG8_WAIT_L(0); PG8_MMA(0, 1, At, B1); PG8_BAR;
            PG8_LDA(At, 0, 1); PG8_STAGE(PG8_SA(0, 0), a2, voffA);
            PG8_BAR; PG8_WAIT_L(0); PG8_MMA(1, 0, At, B0); PG8_BAR; PG8_SCHED;
            PG8_STAGE(PG8_SB(0, 1), b2 + hstep, voffB);
            PG8_WAIT_V(6); PG8_BAR; PG8_MMA(1, 1, At, B1); PG8_BAR;
            PG8_LDB(B0, 1, 0); PG8_SCHED; PG8_LDA(At, 1, 0); PG8_STAGE(PG8_SA(0, 1), a2 + hstep, voffA);
            PG8_WAIT_L(8); PG8_BAR; PG8_WAIT_L(0); PG8_MMA(0, 0, At, B0); PG8_BAR; PG8_SCHED;
            PG8_LDB(B1, 1, 1); PG8_STAGE(PG8_SB(1, 0), b3, voffB);
            PG8_BAR; PG8_WAIT_L(0); PG8_MMA(0, 1, At, B1); PG8_BAR;
            PG8_LDA(At, 1, 1); PG8_STAGE(PG8_SA(1, 0), a3, voffA);
            PG8_BAR; PG8_WAIT_L(0); PG8_MMA(1, 0, At, B0); PG8_BAR; PG8_SCHED;
            PG8_STAGE(PG8_SB(1, 1), b3 + hstep, voffB);
            PG8_WAIT_V(6); PG8_BAR; PG8_MMA(1, 1, At, B1); PG8_BAR;
            }
        }
        if constexpr (ALIGN_EPI) { if (wr == 0) PG8_BAR; }
        if constexpr (!Epi::AFTER_DRAIN) { E(acc, cur, wr, wc, fr, fq); S.done(cur); }
        if (!has_next) break;
        bool keep_ = false; if constexpr (Epi::CHAIN) keep_ = E.keep(cur);
        if (!keep_) {
#pragma unroll
        for (int a = 0; a < 2; ++a)
#pragma unroll
            for (int b = 0; b < 2; ++b)
#pragma unroll
                for (int m = 0; m < 4; ++m)
#pragma unroll
                    for (int n = 0; n < 2; ++n) acc[a][b][m][n] = (f32x4){0.f, 0.f, 0.f, 0.f};
        }
        cur = nxt; cA = nA; cB = nB; ++ui;
        if constexpr (ALIGN_EPI) { if (wr == 1) PG8_BAR; }
    }
    PG8_WAIT_V(0);
    if constexpr (!ALIGN_EPI) { if (wr == 0) PG8_BAR; }
    PG8_BAR;
    if constexpr (Epi::AFTER_DRAIN) { E.fused(acc, cur, wr, wc, fr, fq, lds, wid, lane); S.done(cur); }
#undef PG8_SA
#undef PG8_SB
#undef PG8_STAGE
#undef PG8_LDA
#undef PG8_LDB
#undef PG8_MMA
#undef PG8_WAIT_V
#undef PG8_WAIT_L
#undef PG8_BAR
#undef PG8_SCHED
}
}
namespace att {
#define LAS __attribute__((address_space(3)))
typedef unsigned short bf16_t;
typedef short bf16x8 __attribute__((ext_vector_type(8)));
typedef short s16x4 __attribute__((ext_vector_type(4)));
typedef short v4i16_t __attribute__((ext_vector_type(4)));
typedef float f32x16 __attribute__((ext_vector_type(16)));
typedef float f32x4 __attribute__((ext_vector_type(4)));
typedef unsigned u32x4 __attribute__((ext_vector_type(4)));
typedef unsigned u32x2 __attribute__((ext_vector_type(2)));
constexpr int SEQ = 2048, PITCH = 512, MROWS = 32768;
constexpr size_t BUF = (size_t)MROWS * 512;
constexpr float LOG2E = 1.4426950408889634f, C2 = 0.125f * LOG2E;
constexpr int TAB_OFF = 65536, BC_OFF = 131072 + 512, FL_OFF = BC_OFF + 64, PRM_OFF = 131072 + 4096;
using pg8::cvt_pk_bf16; using pg8::bf_lo; using pg8::bf_hi;
#define MFMA32(a, b, c) __builtin_amdgcn_mfma_f32_32x32x16_bf16((a), (b), (c), 0, 0, 0)
__device__ __forceinline__ s16x4 vtr(const LAS unsigned char* p) { return __builtin_bit_cast(s16x4, __builtin_amdgcn_ds_read_tr16_b64_v4i16((LAS v4i16_t*)p)); }
__device__ __forceinline__ u32x4 scale8(u32x4 v, float s) { u32x4 o; o.x = cvt_pk_bf16(bf_lo(v.x) * s, bf_hi(v.x) * s); o.y = cvt_pk_bf16(bf_lo(v.y) * s, bf_hi(v.y) * s); o.z = cvt_pk_bf16(bf_lo(v.z) * s, bf_hi(v.z) * s); o.w = cvt_pk_bf16(bf_lo(v.w) * s, bf_hi(v.w) * s); return o; }
__device__ __forceinline__ bf16x8 pack8(const f32x16& p, int s) { u32x4 w; w.x = cvt_pk_bf16(p[8 * s], p[8 * s + 1]); w.y = cvt_pk_bf16(p[8 * s + 2], p[8 * s + 3]); w.z = cvt_pk_bf16(p[8 * s + 4], p[8 * s + 5]); w.w = cvt_pk_bf16(p[8 * s + 6], p[8 * s + 7]); return __builtin_bit_cast(bf16x8, w); }
__device__ __forceinline__ float wave_sum(float v) {
#pragma unroll
    for (int o = 1; o < 64; o <<= 1) v += __shfl_xor(v, o);
    return v; }
struct AttnArgs { GAS bf16_t* qkv; GAS bf16_t* obase; const GAS float* ss; const GAS float* qk_g_diff; const GAS float* lambda_qk; const GAS float* subln_g; const GAS float* qk_g_ch; const GAS float* rel_bias; float lam_init; };

__device__ __forceinline__ void qkt(f32x16& p0, f32x16& p1, const LAS unsigned char* kimg, const bf16x8* qr, int r32, int hi, float cinit = 0.f) {
    const LAS unsigned char* kb = kimg + hi * 1024 + r32 * 16;
#pragma unroll
    for (int r = 0; r < 16; ++r) { p0[r] = cinit; p1[r] = cinit; }
    bf16x8 kf[8];
#pragma unroll
    for (int d0 = 0; d0 < 4; ++d0) { kf[2 * d0] = *(const LAS bf16x8*)(kb + d0 * 2048); kf[2 * d0 + 1] = *(const LAS bf16x8*)(kb + d0 * 2048 + 512); }
    __builtin_amdgcn_sched_barrier(0);
#pragma unroll
    for (int d0 = 0; d0 < 4; ++d0) { p0 = MFMA32(kf[2 * d0], qr[d0], p0); p1 = MFMA32(kf[2 * d0 + 1], qr[d0], p1); }
    __builtin_amdgcn_sched_barrier(0);
}
template <int NB> __device__ __forceinline__ void pv(f32x16* o, const LAS unsigned char* vimg, int vl, const f32x16& p0, const f32x16& p1) {
    const bf16x8 pf[4] = {pack8(p0, 0), pack8(p0, 1), pack8(p1, 0), pack8(p1, 1)};
    s16x4 lo[2][4], hh[2][4];
#pragma unroll
    for (int ks = 0; ks < 4; ++ks) { const LAS unsigned char* vp = vimg + vl + ks * 1024; lo[0][ks] = vtr(vp); hh[0][ks] = vtr(vp + 512); }
#pragma unroll
    for (int blk = 0; blk < NB; ++blk) {
        if (blk + 1 < NB) {
#pragma unroll
            for (int ks = 0; ks < 4; ++ks) { const LAS unsigned char* vp = vimg + vl + (blk + 1) * 4096 + ks * 1024; lo[(blk + 1) & 1][ks] = vtr(vp); hh[(blk + 1) & 1][ks] = vtr(vp + 512); } }
        __builtin_amdgcn_sched_barrier(0);
#pragma unroll
        for (int ks = 0; ks < 4; ++ks) { const s16x4 a = lo[blk & 1][ks], b = hh[blk & 1][ks];
            const bf16x8 vf = (bf16x8){a[0], a[1], a[2], a[3], b[0], b[1], b[2], b[3]};
            o[blk] = MFMA32(vf, pf[ks], o[blk]); }
        __builtin_amdgcn_sched_barrier(0);
    }
}
__device__ __forceinline__ void qkt_half(f32x16& p, const LAS unsigned char* kimg, const bf16x8* qr, int r32, int hi, float cinit, int half) {
    const LAS unsigned char* kb = kimg + hi * 1024 + r32 * 16 + half * 512;
#pragma unroll
    for (int r = 0; r < 16; ++r) p[r] = cinit;
    bf16x8 kf[4];
#pragma unroll
    for (int d0 = 0; d0 < 4; ++d0) kf[d0] = *(const LAS bf16x8*)(kb + d0 * 2048);
#pragma unroll
    for (int d0 = 0; d0 < 4; ++d0) p = MFMA32(kf[d0], qr[d0], p);
}
template <int NB> __device__ __forceinline__ void pv_half(f32x16* o, const LAS unsigned char* vimg, int vl, const f32x16& p, int half) {
    const bf16x8 pf[2] = {pack8(p, 0), pack8(p, 1)};
#pragma unroll
    for (int blk = 0; blk < NB; ++blk) { s16x4 lo[2], hh[2];
#pragma unroll
        for (int ks = 0; ks < 2; ++ks) { const LAS unsigned char* vp = vimg + vl + blk * 4096 + (2 * half + ks) * 1024; lo[ks] = vtr(vp); hh[ks] = vtr(vp + 512); }
#pragma unroll
        for (int ks = 0; ks < 2; ++ks) { const bf16x8 vf = (bf16x8){lo[ks][0], lo[ks][1], lo[ks][2], lo[ks][3], hh[ks][0], hh[ks][1], hh[ks][2], hh[ks][3]};
            o[blk] = MFMA32(vf, pf[ks], o[blk]); } }
}
template <int NB> __device__ __forceinline__ void store_o(GAS bf16_t* orow, const f32x16* o, int hi) {
#pragma unroll
    for (int blk = 0; blk < NB; ++blk)
#pragma unroll
        for (int i = 0; i < 4; ++i) { u32x2 w; w.x = cvt_pk_bf16(o[blk][4 * i], o[blk][4 * i + 1]); w.y = cvt_pk_bf16(o[blk][4 * i + 2], o[blk][4 * i + 3]);
            *(GAS u32x2*)(orow + blk * 32 + 8 * i + 4 * hi) = w; }
}

template <int VAR, bool FIX> __device__ __forceinline__ void unit_ac(const AttnArgs& A, int b, int h, int qb, LAS unsigned char* lds, float shift) {
    int tid_ = threadIdx.x; asm volatile("" : "+v"(tid_));
    const int tid = tid_, lane = tid & 63, r32 = lane & 31, hi = lane >> 5; const int wid = __builtin_amdgcn_readfirstlane(tid >> 6);
    const size_t rowbase = (size_t)b * SEQ; const int q0 = qb * 256;
    if (wid < 4) __builtin_amdgcn_s_setprio(2); else __builtin_amdgcn_s_setprio(0);
    GAS bf16_t* qkv_ = A.qkv; const GAS float* ss_ = A.ss; asm volatile("" : "+s"(qkv_), "+s"(ss_));
    GAS bf16_t* Qb = qkv_ + (VAR == 0 ? 0 : 2) * BUF; const GAS bf16_t* Kb = qkv_ + (VAR == 0 ? 3 : 7) * BUF; const GAS bf16_t* Vb = qkv_ + (VAR == 0 ? 4 : 8) * BUF;
    const GAS float* ssq = ss_ + (size_t)1 * MROWS * 16; const GAS float* ssk = ss_ + (size_t)3 * MROWS * 16;
    const int qrow = q0 + wid * 32 + r32;
    bf16x8 qr[4];
    { const GAS bf16_t* qp = Qb + (rowbase + qrow) * PITCH + h * 64; float qs = C2;
      if (VAR == 2) { const GAS float* s = ssq + (rowbase + qrow) * 16 + 2 * h; qs = C2 * __builtin_amdgcn_rsqf((s[0] + s[1]) * (1.0f / 64.0f) + 1e-6f); }
#pragma unroll
      for (int d0 = 0; d0 < 4; ++d0) { const u32x4 raw = *(const GAS u32x4*)(qp + d0 * 16 + hi * 8); u32x4 w;
          if (VAR == 2) { const LAS float* g = (const LAS float*)(lds + PRM_OFF) + 96 + d0 * 16 + hi * 8; const f32x4 a0 = *(const LAS f32x4*)g * qs, a1 = *(const LAS f32x4*)(g + 4) * qs;
              w.x = cvt_pk_bf16(bf_lo(raw.x) * a0[0], bf_hi(raw.x) * a0[1]); w.y = cvt_pk_bf16(bf_lo(raw.y) * a0[2], bf_hi(raw.y) * a0[3]);
              w.z = cvt_pk_bf16(bf_lo(raw.z) * a1[0], bf_hi(raw.z) * a1[1]); w.w = cvt_pk_bf16(bf_lo(raw.w) * a1[2], bf_hi(raw.w) * a1[3]); }
          else w = scale8(raw, qs);
          qr[d0] = __builtin_bit_cast(bf16x8, w); } }
    const int t_hi = 4 * qb + 3, t_lo = (VAR == 0) ? 0 : ((4 * qb - 8) > 0 ? (4 * qb - 8) : 0), nT = t_hi - t_lo + 1;
    const int tw = 4 * qb + (wid >> 1);
    if (VAR == 2) { LAS float* T = (LAS float*)(lds + TAB_OFF);
        for (int j = tid; j < 640; j += 512) { int d = j - 63; d = d < -128 ? -128 : (d > 128 ? 128 : d); T[j] = A.rel_bias[h * 257 + d + 128] * LOG2E; } }
    const GAS bf16_t* ksrc = Kb + (rowbase + lane) * PITCH + h * 64 + wid * 8;
    const GAS bf16_t* vsrc = Vb + (rowbase + 16 * (wid & 3) + (lane >> 2)) * PITCH + h * 64 + (wid >> 2) * 32 + (lane & 3) * 8;
    const GAS float* ksst = ssk + (rowbase + lane) * 16 + 2 * h;
    const int sdst = wid * 1024 + lane * 16;
    u32x4 kreg, vreg;
    float ks0 = 0.f, ks1 = 0.f;
#define LOAD_T(t) do { kreg = *(const GAS u32x4*)(ksrc + (size_t)(t) * 64 * PITCH); vreg = *(const GAS u32x4*)(vsrc + (size_t)(t) * 64 * PITCH); \
        if (VAR == 2) { const GAS float* s_ = ksst + (size_t)(t) * 64 * 16; ks0 = s_[0]; ks1 = s_[1]; } } while (0)
#define WRITE_T(st) do { if (VAR == 2) kreg = scale8(kreg, __builtin_amdgcn_rsqf((ks0 + ks1) * (1.0f / 64.0f) + 1e-6f)); \
        *(LAS u32x4*)(lds + (st) * 16384 + sdst) = kreg; *(LAS u32x4*)(lds + (st) * 16384 + 8192 + sdst) = vreg; } while (0)
#define TILE(i) ((VAR == 0) ? (t_hi - (i)) : (t_lo + (i)))
    const int vl = (4 * hi + ((lane & 15) >> 2)) * 64 + ((lane >> 4) & 1) * 32 + (lane & 3) * 8;
    f32x16 o[2]; o[0] = f32x16{}; o[1] = f32x16{};
    float m_run = -1e30f, l_run = 0.f, pc = 1.0f;
    LOAD_T(TILE(0)); WRITE_T(0); __syncthreads();
    for (int i = 0; i < nT; ++i) {
        const int t = TILE(i); const int st = i & 1;
        if (i + 1 < nT) LOAD_T(TILE(i + 1));
        const bool wdone = (VAR == 0) && (__builtin_amdgcn_ballot_w64(pc != 0.0f) == 0ull);
        const bool active = (VAR == 0) ? (t <= tw && !wdone) : (t <= tw && t >= tw - 8);
        if (active) {
            f32x16 p0, p1;
            if (VAR == 2 && FIX) {
                const LAS float* T = (const LAS float*)(lds + TAB_OFF);
                const bool far = (t <= tw - 3);
                const LAS unsigned char* kimg = lds + st * 16384; const LAS unsigned char* vimg = lds + st * 16384 + 8192;
                const LAS float* Tq = T + (qrow + 63 - 64 * t - 4 * hi);
                float sum0 = 0.f, sum1 = 0.f;
                if (far) {
                    const float ci = T[639] - shift;
                    qkt_half(p0, kimg, qr, r32, hi, ci, 0); qkt_half(p1, kimg, qr, r32, hi, ci, 1);
#pragma unroll
                    for (int r = 0; r < 16; ++r) { p0[r] = __builtin_amdgcn_exp2f(p0[r]); sum0 += p0[r]; }
                    pv_half<2>(o, vimg, vl, p0, 0);
#pragma unroll
                    for (int r = 0; r < 16; ++r) { p1[r] = __builtin_amdgcn_exp2f(p1[r]); sum1 += p1[r]; }
                    pv_half<2>(o, vimg, vl, p1, 1);
                } else {
                    qkt_half(p0, kimg, qr, r32, hi, -shift, 0); qkt_half(p1, kimg, qr, r32, hi, -shift, 1);
#pragma unroll
                    for (int r = 0; r < 16; ++r) { const int kk = (r & 3) + 8 * (r >> 2); p0[r] = __builtin_amdgcn_exp2f(p0[r] + Tq[-kk]); sum0 += p0[r]; }
                    pv_half<2>(o, vimg, vl, p0, 0);
#pragma unroll
                    for (int r = 0; r < 16; ++r) { const int kk = (r & 3) + 8 * (r >> 2); p1[r] = __builtin_amdgcn_exp2f(p1[r] + Tq[-kk - 32]); sum1 += p1[r]; }
                    pv_half<2>(o, vimg, vl, p1, 1);
                }
                l_run += sum0 + sum1;
            } else if (VAR == 2) {
                qkt(p0, p1, lds + st * 16384, qr, r32, hi);
                const LAS float* T = (const LAS float*)(lds + TAB_OFF) + (qrow + 63 - 64 * t - 4 * hi);
#pragma unroll
                for (int r = 0; r < 16; ++r) { const int kk = (r & 3) + 8 * (r >> 2); p0[r] += T[-kk]; p1[r] += T[-kk - 32]; }
                float mx = p0[0];
#pragma unroll
                for (int r = 1; r < 16; ++r) mx = fmaxf(mx, p0[r]);
#pragma unroll
                for (int r = 0; r < 16; ++r) mx = fmaxf(mx, p1[r]);
                mx = fmaxf(mx, __shfl_xor(mx, 32));
                const float mn = fmaxf(m_run, mx), alpha = __builtin_amdgcn_exp2f(m_run - mn); m_run = mn;
                float sum = 0.f;
#pragma unroll
                for (int r = 0; r < 16; ++r) { p0[r] = __builtin_amdgcn_exp2f(p0[r] - mn); p1[r] = __builtin_amdgcn_exp2f(p1[r] - mn); sum += p0[r] + p1[r]; }
                l_run = l_run * alpha + sum;
#pragma unroll
                for (int r = 0; r < 16; ++r) { o[0][r] *= alpha; o[1][r] *= alpha; }
            } else {
                qkt(p0, p1, lds + st * 16384, qr, r32, hi);
                const bool diag = (t == tw); const int qd = (wid & 1) * 32 + r32;
                float G[16];
#pragma unroll
                for (int p = 0; p < 2; ++p)
#pragma unroll
                    for (int i4 = 0; i4 < 4; ++i4) { float rr[4];
#pragma unroll
                        for (int j = 0; j < 4; ++j) { const float z = p ? p1[4 * i4 + j] : p0[4 * i4 + j]; float rv = __builtin_amdgcn_rcpf(1.0f + __builtin_amdgcn_exp2f(fminf(z, 80.f)));
                            if (diag) { const int kk = 32 * p + 8 * i4 + 4 * hi + j; if (kk >= qd) rv = 1.0f; }
                            rr[j] = rv; }
                        const float sc = rr[3], sb = rr[3] * rr[2], sa = sb * rr[1], R = sa * rr[0];
                        const float w0 = (1.0f - rr[0]) * sa, w1 = (1.0f - rr[1]) * sb, w2 = (1.0f - rr[2]) * sc, w3 = (1.0f - rr[3]);
                        if (p) { p1[4 * i4] = w0; p1[4 * i4 + 1] = w1; p1[4 * i4 + 2] = w2; p1[4 * i4 + 3] = w3; } else { p0[4 * i4] = w0; p0[4 * i4 + 1] = w1; p0[4 * i4 + 2] = w2; p0[4 * i4 + 3] = w3; }
                        const float Ro = __shfl_xor(R, 32);
                        G[2 * (4 * p + i4)] = hi ? Ro : R; G[2 * (4 * p + i4) + 1] = hi ? R : Ro; }
                float Ee[8], Eo[8]; Eo[7] = pc;
#pragma unroll
                for (int q = 7; q >= 0; --q) { Ee[q] = Eo[q] * G[2 * q + 1]; if (q > 0) Eo[q - 1] = Ee[q] * G[2 * q]; }
                pc = Ee[0] * G[0];
#pragma unroll
                for (int q = 0; q < 8; ++q) { const float e = hi ? Eo[q] : Ee[q];
#pragma unroll
                    for (int j = 0; j < 4; ++j) { if (q < 4) p0[4 * q + j] *= e; else p1[4 * (q - 4) + j] *= e; } }
            }
            if (!(VAR == 2 && FIX)) pv<2>(o, lds + st * 16384 + 8192, vl, p0, p1);
        }
        if (i + 1 < nT) WRITE_T(st ^ 1);
        if (VAR == 0) { const bool wd2 = (__builtin_amdgcn_ballot_w64(pc != 0.0f) == 0ull); if (lane == 0) ((LAS unsigned*)(lds + FL_OFF))[st * 8 + wid] = wd2 ? 1u : 0u; }
        __syncthreads();
        if (VAR == 0) { const LAS unsigned* fl = (const LAS unsigned*)(lds + FL_OFF) + st * 8; const unsigned all = fl[0] & fl[1] & fl[2] & fl[3] & fl[4] & fl[5] & fl[6] & fl[7];
            if (__builtin_amdgcn_readfirstlane(all)) break; }
    }
    if (VAR == 2) { const float lt = l_run + __shfl_xor(l_run, 32), inv = __builtin_amdgcn_rcpf(lt);
#pragma unroll
        for (int r = 0; r < 16; ++r) { o[0][r] *= inv; o[1][r] *= inv; } }
    store_o<2>(A.obase + (VAR == 0 ? 0 : 2) * BUF + (rowbase + qrow) * PITCH + h * 64, o, hi);
#undef LOAD_T
#undef WRITE_T
#undef TILE
}

__device__ __forceinline__ void unit_a4(const AttnArgs& A, int b, int hg, int c, LAS unsigned char* lds) {
    int tid_ = threadIdx.x; asm volatile("" : "+v"(tid_));
    const int tid = tid_, lane = tid & 63, r32 = lane & 31, hi = lane >> 5; const int wid = __builtin_amdgcn_readfirstlane(tid >> 6);
    const int hh = wid >> 1, h = 4 * hg + hh;
    const size_t rowbase = (size_t)b * SEQ;
    if (wid < 4) __builtin_amdgcn_s_setprio(2); else __builtin_amdgcn_s_setprio(0);
    GAS bf16_t* qkv_ = A.qkv; asm volatile("" : "+s"(qkv_));
    GAS bf16_t* Qb = qkv_; const GAS bf16_t* Kb = qkv_ + 3 * BUF; const GAS bf16_t* Vb = qkv_ + 4 * BUF;
    const int qd = (wid & 1) * 32 + r32, qrow = 64 * c + qd;
    bf16x8 qr[4];
    { const GAS bf16_t* qp = Qb + (rowbase + qrow) * PITCH + h * 64;
#pragma unroll
      for (int d0 = 0; d0 < 4; ++d0) qr[d0] = __builtin_bit_cast(bf16x8, scale8(*(const GAS u32x4*)(qp + d0 * 16 + hi * 8), C2)); }
    const GAS bf16_t* ksrc = Kb + (rowbase + lane) * PITCH + hg * 256 + wid * 8;
    const GAS bf16_t* vsrc = Vb + (rowbase + 16 * (wid & 3) + (lane >> 2)) * PITCH + hg * 256 + (wid >> 2) * 32 + (lane & 3) * 8;
    const int sdst = wid * 1024 + lane * 16;
    u32x4 kr[4], vr[4];
#define LOAD_T(t) do { const size_t o_ = (size_t)(t) * 64 * PITCH; _Pragma("unroll") for (int j = 0; j < 4; ++j) { kr[j] = *(const GAS u32x4*)(ksrc + o_ + j * 64); vr[j] = *(const GAS u32x4*)(vsrc + o_ + j * 64); } } while (0)
#define WRITE_T(st) do { _Pragma("unroll") for (int j = 0; j < 4; ++j) { *(LAS u32x4*)(lds + (st) * 65536 + j * 8192 + sdst) = kr[j]; *(LAS u32x4*)(lds + (st) * 65536 + 32768 + j * 8192 + sdst) = vr[j]; } } while (0)
    const int vl = (4 * hi + ((lane & 15) >> 2)) * 64 + ((lane >> 4) & 1) * 32 + (lane & 3) * 8;
    f32x16 o[2]; o[0] = f32x16{}; o[1] = f32x16{};
    float pc = 1.0f;
    const int nT = c + 1;
    LOAD_T(c); WRITE_T(0); __syncthreads();
    for (int i = 0; i < nT; ++i) {
        const int t = c - i; const int st = i & 1;
        if (i + 1 < nT) LOAD_T(t - 1);
        const bool wdone = (__builtin_amdgcn_ballot_w64(pc != 0.0f) == 0ull);
        if (!wdone) {
            f32x16 p0, p1; qkt(p0, p1, lds + st * 65536 + hh * 8192, qr, r32, hi);
            const bool diag = (i == 0);
            float G[16];
#pragma unroll
            for (int p = 0; p < 2; ++p)
#pragma unroll
                for (int i4 = 0; i4 < 4; ++i4) { float rr[4];
#pragma unroll
                    for (int j = 0; j < 4; ++j) { const float z = p ? p1[4 * i4 + j] : p0[4 * i4 + j]; float rv = __builtin_amdgcn_rcpf(1.0f + __builtin_amdgcn_exp2f(fminf(z, 80.f)));
                        if (diag) { const int kk = 32 * p + 8 * i4 + 4 * hi + j; if (kk >= qd) rv = 1.0f; }
                        rr[j] = rv; }
                    const float sc = rr[3], sb = rr[3] * rr[2], sa = sb * rr[1], R = sa * rr[0];
                    const float w0 = (1.0f - rr[0]) * sa, w1 = (1.0f - rr[1]) * sb, w2 = (1.0f - rr[2]) * sc, w3 = (1.0f - rr[3]);
                    if (p) { p1[4 * i4] = w0; p1[4 * i4 + 1] = w1; p1[4 * i4 + 2] = w2; p1[4 * i4 + 3] = w3; } else { p0[4 * i4] = w0; p0[4 * i4 + 1] = w1; p0[4 * i4 + 2] = w2; p0[4 * i4 + 3] = w3; }
                    const float Ro = __shfl_xor(R, 32);
                    G[2 * (4 * p + i4)] = hi ? Ro : R; G[2 * (4 * p + i4) + 1] = hi ? R : Ro; }
            float Ee[8], Eo[8]; Eo[7] = pc;
#pragma unroll
            for (int q = 7; q >= 0; --q) { Ee[q] = Eo[q] * G[2 * q + 1]; if (q > 0) Eo[q - 1] = Ee[q] * G[2 * q]; }
            pc = Ee[0] * G[0];
#pragma unroll
            for (int q = 0; q < 8; ++q) { const float e = hi ? Eo[q] : Ee[q];
#pragma unroll
                for (int j = 0; j < 4; ++j) { if (q < 4) p0[4 * q + j] *= e; else p1[4 * (q - 4) + j] *= e; } }
            pv<2>(o, lds + st * 65536 + 32768 + hh * 8192, vl, p0, p1);
        }
        if (i + 1 < nT) WRITE_T(st ^ 1);
        { const bool wd2 = (__builtin_amdgcn_ballot_w64(pc != 0.0f) == 0ull); if (lane == 0) ((LAS unsigned*)(lds + FL_OFF))[st * 8 + wid] = wd2 ? 1u : 0u; }
        __syncthreads();
        { const LAS unsigned* fl = (const LAS unsigned*)(lds + FL_OFF) + st * 8; const unsigned all = fl[0] & fl[1] & fl[2] & fl[3] & fl[4] & fl[5] & fl[6] & fl[7];
          if (__builtin_amdgcn_readfirstlane(all)) break; }
    }
    store_o<2>(A.obase + (rowbase + qrow) * PITCH + h * 64, o, hi);
#undef LOAD_T
#undef WRITE_T
}

__device__ __forceinline__ void unit_b(const AttnArgs& A, int b, int h, int qb, LAS unsigned char* lds) {
    int tid_ = threadIdx.x; asm volatile("" : "+v"(tid_));
    const int tid = tid_, lane = tid & 63, r32 = lane & 31, hi = lane >> 5; const int wid = __builtin_amdgcn_readfirstlane(tid >> 6);
    const int mp = wid >> 2, g4 = wid & 3;
    if (wid < 4) __builtin_amdgcn_s_setprio(2); else __builtin_amdgcn_s_setprio(0);
    const size_t rowbase = (size_t)b * SEQ; const int q0 = qb * 128;
    GAS bf16_t* qkv_ = A.qkv; const GAS float* ss_ = A.ss; asm volatile("" : "+s"(qkv_), "+s"(ss_));
    GAS bf16_t* Qb = qkv_ + 1 * BUF; const GAS bf16_t* Kb = qkv_ + 5 * BUF; const GAS bf16_t* Vb = qkv_ + 6 * BUF;
    const GAS float* ssq = ss_; const GAS float* ssk = ss_ + (size_t)2 * MROWS * 16;
    const int qrow = q0 + g4 * 32 + r32;
    const LAS float* prm = (const LAS float*)(lds + PRM_OFF); const float lam = prm[0], M0 = prm[1];
    bf16x8 qr[4];
    { const GAS bf16_t* qp = Qb + (rowbase + qrow) * PITCH + h * 128 + mp * 64; const GAS float* s = ssq + (rowbase + qrow) * 16 + 4 * h + 2 * mp;
      const float qs = C2 * __builtin_amdgcn_rsqf((s[0] + s[1]) * (1.0f / 64.0f) + 1e-6f);
#pragma unroll
      for (int d0 = 0; d0 < 4; ++d0) { const u32x4 raw = *(const GAS u32x4*)(qp + d0 * 16 + hi * 8); u32x4 w;
          const LAS float* g = prm + 32 + d0 * 16 + hi * 8; const f32x4 a0 = *(const LAS f32x4*)g * qs, a1 = *(const LAS f32x4*)(g + 4) * qs;
          w.x = cvt_pk_bf16(bf_lo(raw.x) * a0[0], bf_hi(raw.x) * a0[1]); w.y = cvt_pk_bf16(bf_lo(raw.y) * a0[2], bf_hi(raw.y) * a0[3]);
          w.z = cvt_pk_bf16(bf_lo(raw.z) * a1[0], bf_hi(raw.z) * a1[1]); w.w = cvt_pk_bf16(bf_lo(raw.w) * a1[2], bf_hi(raw.w) * a1[3]);
          qr[d0] = __builtin_bit_cast(bf16x8, w); } }
    const int nT = 2 * qb + 2; const int tw = 2 * qb + (g4 >> 1);
    const float slope2 = LOG2E * exp2f(-2.0f * (float)(h + 1));
    const GAS bf16_t* ksrc = Kb + (rowbase + lane) * PITCH + h * 128 + wid * 8;
    const GAS bf16_t* vsrc0 = Vb + (rowbase + 16 * (wid & 3) + (lane >> 2)) * PITCH + h * 128 + (wid >> 2) * 32 + (lane & 3) * 8;
    const GAS float* ksst = ssk + (rowbase + lane) * 16 + 4 * h;
    const int sdst = wid * 1024 + lane * 16;
    u32x4 k0r, k1r, v0r, v1r;
    f32x4 kss = {0.f, 0.f, 0.f, 0.f};
#define LOAD_T(t) do { const size_t o_ = (size_t)(t) * 64 * PITCH; k0r = *(const GAS u32x4*)(ksrc + o_); k1r = *(const GAS u32x4*)(ksrc + o_ + 64); v0r = *(const GAS u32x4*)(vsrc0 + o_); v1r = *(const GAS u32x4*)(vsrc0 + o_ + 64); \
        kss = *(const GAS f32x4*)(ksst + (size_t)(t) * 64 * 16); } while (0)
#define WRITE_T(st) do { LAS unsigned char* d_ = lds + (st) * 32768 + sdst; k0r = scale8(k0r, __builtin_amdgcn_rsqf((kss[0] + kss[1]) * (1.0f / 64.0f) + 1e-6f)); k1r = scale8(k1r, __builtin_amdgcn_rsqf((kss[2] + kss[3]) * (1.0f / 64.0f) + 1e-6f)); *(LAS u32x4*)(d_) = k0r; *(LAS u32x4*)(d_ + 8192) = k1r; *(LAS u32x4*)(d_ + 16384) = v0r; *(LAS u32x4*)(d_ + 16384 + 8192) = v1r; } while (0)
    const int vl = (4 * hi + ((lane & 15) >> 2)) * 64 + ((lane >> 4) & 1) * 32 + (lane & 3) * 8;
    f32x16 o[4]; o[0] = f32x16{}; o[1] = f32x16{}; o[2] = f32x16{}; o[3] = f32x16{};
    float l_run = 0.f;
    const int tfirst = [&] { const float dcut = 150.0f / slope2; const float x = ((float)(q0 - 63) - dcut) * (1.0f / 64.0f); int t0 = (x > 0.f) ? (int)x + 1 : 0; return t0 < nT - 1 ? t0 : nT - 1; }();
    LOAD_T(tfirst); WRITE_T(tfirst & 1); __syncthreads();
    for (int t = tfirst; t < nT; ++t) {
        const int st = t & 1;
        if (t + 1 < nT) LOAD_T(t + 1);
        if (t <= tw) {
            f32x16 p0, p1;
            const LAS unsigned char* kimg = lds + st * 32768 + mp * 8192; const LAS unsigned char* vimg = lds + st * 32768 + 16384;
            qkt_half(p0, kimg, qr, r32, hi, -M0, 0); qkt_half(p1, kimg, qr, r32, hi, -M0, 1);
            const float dq = (float)(qrow - 64 * t - 4 * hi);
            float sum0 = 0.f, sum1 = 0.f;
#pragma unroll
            for (int r = 0; r < 16; ++r) { const float kk = (float)((r & 3) + 8 * (r >> 2)); p0[r] = __builtin_amdgcn_exp2f(p0[r] - slope2 * fabsf(dq - kk)); sum0 += p0[r]; }
            pv_half<4>(o, vimg, vl, p0, 0);
#pragma unroll
            for (int r = 0; r < 16; ++r) { const float kk = (float)((r & 3) + 8 * (r >> 2)); p1[r] = __builtin_amdgcn_exp2f(p1[r] - slope2 * fabsf(dq - kk - 32.0f)); sum1 += p1[r]; }
            pv_half<4>(o, vimg, vl, p1, 1);
            l_run += sum0 + sum1;
        }
        if (t + 1 < nT) WRITE_T(st ^ 1);
        __syncthreads();
    }
    const float lt = l_run + __shfl_xor(l_run, 32), inv = __builtin_amdgcn_rcpf(lt);
    LAS float* X = (LAS float*)lds;
    const int xr = g4 * 32 + r32;
    if (mp == 1) { const float f = inv * lam;
#pragma unroll
        for (int bk = 0; bk < 4; ++bk)
#pragma unroll
            for (int r = 0; r < 16; ++r) X[(bk * 32 + (r & 3) + 8 * (r >> 2) + 4 * hi) * 128 + xr] = o[bk][r] * f; }
    __syncthreads();
    if (mp == 0) { float sq = 0.f;
#pragma unroll
        for (int bk = 0; bk < 4; ++bk)
#pragma unroll
            for (int r = 0; r < 16; ++r) { const float v = o[bk][r] * inv - X[(bk * 32 + (r & 3) + 8 * (r >> 2) + 4 * hi) * 128 + xr]; o[bk][r] = v; sq += v * v; }
        sq += __shfl_xor(sq, 32);
        const float rs = __builtin_amdgcn_rsqf(sq * (1.0f / 128.0f) + 1e-6f);
#pragma unroll
        for (int bk = 0; bk < 4; ++bk)
#pragma unroll
            for (int i = 0; i < 4; ++i) { const f32x4 gv = *(const LAS f32x4*)(prm + 160 + bk * 32 + 8 * i + 4 * hi);
#pragma unroll
                for (int j = 0; j < 4; ++j) o[bk][4 * i + j] *= rs * gv[j]; }
        store_o<4>(A.obase + 1 * BUF + (rowbase + qrow) * PITCH + h * 128, o, hi); }
    __syncthreads();
#undef LOAD_T
#undef WRITE_T
}

__device__ __forceinline__ void attn_phase(const AttnArgs& A, GAS unsigned* counters, LAS unsigned char* lds) {
    LAS unsigned* bc = (LAS unsigned*)(lds + BC_OFF);
    if (threadIdx.x < 64) {
        LAS float* prm = (LAS float*)(lds + PRM_OFF); const int ln = threadIdx.x;
        const GAS float* lq = A.lambda_qk; const float s1 = wave_sum(lq[ln] * lq[64 + ln]), s2 = wave_sum(lq[128 + ln] * lq[192 + ln]);
        const float gb = A.qk_g_diff[ln] * A.qk_g_diff[64 + ln], gc = A.qk_g_ch[ln] * A.qk_g_ch[64 + ln]; float gmb = fabsf(gb), gmc = fabsf(gc);
#pragma unroll
        for (int o_ = 1; o_ < 64; o_ <<= 1) { gmb = fmaxf(gmb, __shfl_xor(gmb, o_)); gmc = fmaxf(gmc, __shfl_xor(gmc, o_)); }
        prm[32 + ln] = gb; prm[96 + ln] = gc; prm[160 + ln] = A.subln_g[ln] * (1.0f - A.lam_init); prm[224 + ln] = A.subln_g[64 + ln] * (1.0f - A.lam_init);
        const float M0c = 8.0f * gmc * LOG2E * 1.02f;
        if (ln == 0) { prm[0] = __expf(s1) - __expf(s2) + A.lam_init; prm[1] = 8.0f * gmb * LOG2E * 1.02f; }
        for (int hc = 0; hc < 8; ++hc) { float bmx = -3.0e38f, bmn = 3.0e38f;
            for (int j = ln; j < 257; j += 64) { const float v = A.rel_bias[hc * 257 + j]; bmx = fmaxf(bmx, v); bmn = fminf(bmn, v); }
#pragma unroll
            for (int o_ = 1; o_ < 64; o_ <<= 1) { bmx = fmaxf(bmx, __shfl_xor(bmx, o_)); bmn = fminf(bmn, __shfl_xor(bmn, o_)); }
            if (ln == 0) { prm[2 + hc] = M0c + bmx * LOG2E; prm[10 + hc] = (2.0f * M0c + (bmx - bmn) * LOG2E < 100.0f) ? 1.0f : 0.0f; } }
    }
    __syncthreads();
    const int x0 = (int)(__builtin_amdgcn_s_getreg((3 << 11) | 20) & 7u);
#pragma unroll 1
    for (int qn = 0; qn < 8; ++qn) {
        const int x = (x0 + qn) & 7; GAS unsigned* counter = counters + 64 * x;
        for (;;) {
            if (threadIdx.x == 0) *bc = __hip_atomic_fetch_add(counter, 1u, __ATOMIC_RELAXED, __HIP_MEMORY_SCOPE_AGENT);
            __syncthreads();
            const int idx = (int)__builtin_amdgcn_readfirstlane(*bc);
            __syncthreads();
            if (idx >= 384) break;
            if (idx < 128) { const int bh = x + 8 * (idx >> 4); unit_b(A, bh >> 2, bh & 3, 15 - (idx & 15), lds); }
            else if (idx < 256) { const int jc = idx - 128; const int bh = x + 8 * (jc >> 3); const int hc = bh & 7;
                const float shift = ((const LAS float*)(lds + PRM_OFF))[2 + hc]; const bool fixc = __builtin_amdgcn_readfirstlane(__float_as_uint(((const LAS float*)(lds + PRM_OFF))[10 + hc])) != 0u;
                if (fixc) unit_ac<2, true>(A, bh >> 3, hc, 7 - (jc & 7), lds, shift);
                else unit_ac<2, false>(A, bh >> 3, hc, 7 - (jc & 7), lds, 0.f); }
            else { const int ja = idx - 256; const int pr = x + 8 * (ja >> 5); unit_a4(A, pr >> 1, pr & 1, 31 - (ja & 31), lds); }
        }
    }
    __builtin_amdgcn_s_setprio(0);
}
#undef LAS
#undef MFMA32
}
#define LAS __attribute__((address_space(3)))
typedef unsigned short bf16_t;
typedef unsigned v4u __attribute__((ext_vector_type(4)));
typedef float f32x4 __attribute__((ext_vector_type(4)));
constexpr int NWAVES = 8;
constexpr int MT = 32768, DM = 1024, NQKV = 4608, NGATE = 3072, NIN = 7680, DFF = 2816, DEPTH = 4;
constexpr size_t MiB = 1u << 20;
constexpr size_t WS_CTL = 0, CTL_BYTES = 65536;
constexpr size_t WS_ROWSS = 1 * MiB, WS_SS = 3 * MiB, WS_RS1 = 11 * MiB;
constexpr size_t WS_WIN = 12 * MiB, WS_WB = 27 * MiB, WS_WOUT = 30 * MiB, WS_WGU = 32 * MiB, WS_WDOWN = 43 * MiB;
constexpr size_t WS_XB = 50 * MiB, WS_QKV = 114 * MiB, WS_G2 = 402 * MiB, WS_MERGED = WS_QKV + 3 * 32 * MiB  , WS_ACT = WS_QKV, WS_END = 466 * MiB;
constexpr int LDS_BYTES = 147456;

__device__ __forceinline__ unsigned f2bf(float f) { unsigned u = __builtin_bit_cast(unsigned, f); return (u + 0x7fffu + ((u >> 16) & 1u)) >> 16; }
__device__ __forceinline__ unsigned pk2(float lo, float hi) { return f2bf(lo) | (f2bf(hi) << 16); }
#define LDS_WAIT() asm volatile("s_waitcnt lgkmcnt(0)" ::: "memory")

template <class RowMap> __device__ __forceinline__ void transpose_item(const GAS float* W, int K, int N, GAS bf16_t* WT, const GAS float* gain, LAS float* scr, int item, int lane, RowMap rm) {
    const int nblk = N / 32, kb = item / nblk, nb = item % nblk, k0 = 64 * kb, n0 = 32 * nb;
    const int kr = lane >> 3, nc = 4 * (lane & 7);
    f32x4 v[8]; float gv[8];
#pragma unroll
    for (int i = 0; i < 8; ++i) { v[i] = *(const GAS f32x4*)(W + (size_t)(k0 + kr + 8 * i) * N + n0 + nc); gv[i] = gain ? gain[k0 + kr + 8 * i] : 1.0f; }
#pragma unroll
    for (int i = 0; i < 8; ++i) { LAS float* d = scr + (kr + 8 * i) * 33 + nc; const f32x4 w = v[i] * gv[i]; d[0] = w[0]; d[1] = w[1]; d[2] = w[2]; d[3] = w[3]; }
    LDS_WAIT(); asm volatile("" ::: "memory");
    const int c = lane & 7;
#pragma unroll
    for (int j = 0; j < 4; ++j) { const int n = (lane >> 3) + 8 * j; const LAS float* s = scr + (8 * c) * 33 + n;
        v4u o; o.x = pk2(s[0 * 33], s[1 * 33]); o.y = pk2(s[2 * 33], s[3 * 33]); o.z = pk2(s[4 * 33], s[5 * 33]); o.w = pk2(s[6 * 33], s[7 * 33]);
        *(GAS v4u*)(WT + (size_t)rm(n0 + n) * K + k0 + 8 * c) = o; }
    LDS_WAIT(); asm volatile("" ::: "memory");
}
struct MapId { int off; __device__ int operator()(int n) const { return off + n; } };
struct MapIn { __device__ int operator()(int n) const { if (n >= 4608) return n; const int s = n >> 9; const int d = (int)((0x872651430ULL >> (4 * s)) & 15ULL); return d * 512 + (n & 511); } };
struct MapGU { __device__ int operator()(int n) const { const int up = n >= 2816 ? 1 : 0; const int c = n - up * 2816; return (c >> 2) * 8 + up * 4 + (c & 3); } };

__device__ __forceinline__ unsigned long long ldptr(volatile LAS unsigned long long* PT, int i) { asm volatile("" : "+v"(PT)); const unsigned long long v = PT[i]; const unsigned lo = __builtin_amdgcn_readfirstlane((unsigned)v), hi = __builtin_amdgcn_readfirstlane((unsigned)(v >> 32)); return ((unsigned long long)hi << 32) | lo; }
#define XB_TMO      128
#define XB_XCNT(j)  (256  + 64 * (j))
#define XB_XSUB(j)  (1280 + 64 * (j))
#define XB_XGEN(j)  (2304 + 64 * (j))
#define XB_TOP      3328
#define XB_TOPGEN   3392
#define XCD_BAR_WORDS 3456
#define XB_SPIN_CAP (1u << 18)

__device__ __forceinline__ unsigned xb_ld(GAS unsigned* p)              { return __hip_atomic_load(p, __ATOMIC_RELAXED, __HIP_MEMORY_SCOPE_AGENT); }
__device__ __forceinline__ unsigned xb_add(GAS unsigned* p, unsigned v) { return __hip_atomic_fetch_add(p, v, __ATOMIC_RELAXED, __HIP_MEMORY_SCOPE_AGENT); }
__device__ __forceinline__ unsigned xb_xcc_id() { return (unsigned)__builtin_amdgcn_s_getreg((3 << 11) | 20) & 0xFu; }
#define XB_SPIN(cond, bar) do { unsigned _sp = 0; while (cond) { __builtin_amdgcn_s_sleep(1); \
    if ((++_sp & 255u) == 0u) { if (xb_ld(&(bar)[XB_TMO])) break; if (_sp > XB_SPIN_CAP) { xb_add(&(bar)[XB_TMO], 1u); break; } } } } while (0)

struct XcdBarrier {
    GAS unsigned* bar; unsigned x;
    volatile LAS unsigned* st;
};

__device__ __forceinline__ XcdBarrier xcd_barrier_post(GAS unsigned* bar, volatile LAS unsigned* st) {
    XcdBarrier b; b.bar = bar; b.x = xb_xcc_id(); b.st = st;
    if (threadIdx.x == 0) (void)xb_add(&bar[XB_XCNT(b.x)], 1u);
    return b;
}
__device__ __forceinline__ void xcd_barrier_complete(GAS unsigned* bar, unsigned x, unsigned& nloc, unsigned& nx) {
    const unsigned G = gridDim.x * gridDim.y * gridDim.z;
    unsigned sum, cnt, mine, sp = 0u;
    for (;;) {
        sum = 0u; cnt = 0u; mine = 0u;
#pragma unroll
        for (unsigned j = 0; j < 16; ++j) { const unsigned c = xb_ld(&bar[XB_XCNT(j)]); sum += c; cnt += (c > 0u) ? 1u : 0u; mine = (j == x) ? c : mine; }
        if (sum == G) break;
        __builtin_amdgcn_s_sleep(1);
        if ((++sp & 255u) == 0u) { if (xb_ld(&bar[XB_TMO])) break; if (sp > XB_SPIN_CAP) { xb_add(&bar[XB_TMO], 1u); break; } }
    }
    nloc = mine > 0u ? mine : 1u; nx = cnt > 0u ? cnt : 1u;
}

__device__ __forceinline__ void xcd_barrier(const XcdBarrier& b) {
    asm volatile("s_waitcnt vmcnt(0)" ::: "memory");
    __syncthreads();
    if (threadIdx.x == 0) {
        GAS unsigned* bar = b.bar;
        __builtin_amdgcn_s_waitcnt(0);
        unsigned nloc = b.st[0], nx = b.st[1];
        if (nloc == 0u) { xcd_barrier_complete(bar, b.x, nloc, nx); b.st[0] = nloc; b.st[1] = nx; }
        const unsigned old = xb_add(&bar[XB_XSUB(b.x)], 1u);
        const unsigned gen = old / nloc;
        if (old + 1u == (gen + 1u) * nloc) {
            __builtin_amdgcn_fence(__ATOMIC_RELEASE, "agent");
            asm volatile("s_waitcnt vmcnt(0)" ::: "memory");
            const unsigned og = xb_add(&bar[XB_TOP], 1u);
            const unsigned tg = og / nx;
            if (og + 1u == (tg + 1u) * nx) xb_add(&bar[XB_TOPGEN], 1u);
            else XB_SPIN(xb_ld(&bar[XB_TOPGEN]) == tg, bar);
            __builtin_amdgcn_fence(__ATOMIC_ACQUIRE, "agent");
            xb_add(&bar[XB_XGEN(b.x)], 1u);
            asm volatile("s_waitcnt vmcnt(0)" ::: "memory");
        } else {
            XB_SPIN(xb_ld(&bar[XB_XGEN(b.x)]) == gen, bar);
            __builtin_amdgcn_fence(__ATOMIC_ACQUIRE, "agent");
            asm volatile("s_waitcnt vmcnt(0)" ::: "memory");
        }
    }
    __syncthreads();
}
struct Args { const GAS float* in[16]; GAS float* out; unsigned char* ws; int ph_lo, ph_hi; };

__global__ void __launch_bounds__(NWAVES * 64, 2) fwd_kernel(Args args) {
    extern __shared__ __attribute__((aligned(16))) unsigned char lds_raw[];
    LAS unsigned char* lds = (LAS unsigned char*)lds_raw;
    cg::grid_group grid = cg::this_grid();
    const int tid = threadIdx.x;
    volatile LAS unsigned long long* PT = (volatile LAS unsigned long long*)(lds + 131072 + 2048);
    { unsigned long long v = (unsigned long long)args.ws;
#pragma unroll
      for (int i = 0; i < 16; ++i) v = (tid == i) ? (unsigned long long)args.in[i] : v;
      v = (tid == 16) ? (unsigned long long)args.out : v;
      if (tid < 18) PT[tid] = v; }
    volatile LAS unsigned* MISC = (volatile LAS unsigned*)(lds + 131072 + 1024);
    if (tid < 2) MISC[tid] = 0u;
    (void)xcd_barrier_post((GAS unsigned*)args.ws + 1024, MISC);
    __syncthreads();
#define PTRF(i) ((const GAS float*)ldptr(PT, (i)))
#define WSP(off) ((GAS unsigned char*)ldptr(PT, 17) + (off))
#define OUTP ((GAS float*)ldptr(PT, 16))
    const int lo = args.ph_lo, hi_ph = args.ph_hi;
#ifndef PHMASK
#define PHMASK 255
#endif
#define REP_G1 1
#define REP_GG 1
#define REP_G2 1
#define REP_G4 1
#define REP_G3 1
#define REP_G5 1
#ifndef REP_ATT
#define REP_ATT 1
#endif
#ifndef REP_P0
#define REP_P0 1
#endif
#ifndef EXTRA_SYNC
#define EXTRA_SYNC 0
#endif
#define IN(k) (((PHMASK >> ((k) & 7)) & 1) && lo <= (k) && (k) < hi_ph)
#define SEAM(k) do { if (IN(k) && IN((k) + 1)) { if ((k) == 0) grid.sync(); else { XcdBarrier xb_; xb_.bar = (GAS unsigned*)WSP(WS_CTL) + 1024; xb_.x = xb_xcc_id(); xb_.st = MISC; xcd_barrier(xb_); } } } while (0)
#pragma unroll 1
    for (int l = 0; l < DEPTH; ++l) {
        const int P = l * 8;
        if (IN(P + 0))
_Pragma("unroll 1")
        for (int rep_ = 0; rep_ < REP_P0; ++rep_) {
            int bid = blockIdx.x, Gl = gridDim.x; asm volatile("" : "+s"(bid), "+s"(Gl));
            int tl = threadIdx.x; asm volatile("" : "+v"(tl)); const int lane = tl & 63, wave = __builtin_amdgcn_readfirstlane(tl >> 6);
            LAS float* scr = (LAS float*)(lds + wave * 16384); const int gw = bid * NWAVES + wave, NGW = Gl * NWAVES;
            const GAS float* w_in = PTRF(2) + (size_t)l * DM * NIN; const GAS float* g_mix = PTRF(1) + (size_t)l * DM;
            const GAS float* w_sb = PTRF(9) + (size_t)l * 512 * DM; const GAS float* w_df = PTRF(10) + (size_t)l * 512 * DM; const GAS float* w_ch = PTRF(11) + (size_t)l * 512 * DM;
            const GAS float* w_out = PTRF(12) + (size_t)l * DM * DM; const GAS float* g_ffn = PTRF(13) + (size_t)l * DM;
            const GAS float* w_gu = PTRF(14) + (size_t)l * DM * 2 * DFF; const GAS float* w_down = PTRF(15) + (size_t)l * DFF * DM;
            constexpr int I_IN = (DM / 64) * (NIN / 32), I_B = (512 / 64) * (DM / 32), I_O = (DM / 64) * (DM / 32), I_GU = (DM / 64) * (2 * DFF / 32), I_DN = (DFF / 64) * (DM / 32);
            constexpr int NITEMS = I_IN + 3 * I_B + I_O + I_GU + I_DN;
            for (int it = gw; it < NITEMS; it += NGW) {
                int r = it;
                if (r < I_IN) { transpose_item(w_in, DM, NIN, ((GAS bf16_t*)WSP(WS_WIN)), g_mix, scr, r, lane, MapIn{}); continue; } r -= I_IN;
                if (r < I_B) { transpose_item(w_sb, 512, DM, ((GAS bf16_t*)WSP(WS_WB)), nullptr, scr, r, lane, MapId{0}); continue; } r -= I_B;
                if (r < I_B) { transpose_item(w_df, 512, DM, ((GAS bf16_t*)WSP(WS_WB)), nullptr, scr, r, lane, MapId{1024}); continue; } r -= I_B;
                if (r < I_B) { transpose_item(w_ch, 512, DM, ((GAS bf16_t*)WSP(WS_WB)), nullptr, scr, r, lane, MapId{2048}); continue; } r -= I_B;
                if (r < I_O) { transpose_item(w_out, DM, DM, ((GAS bf16_t*)WSP(WS_WOUT)), nullptr, scr, r, lane, MapId{0}); continue; } r -= I_O;
                if (r < I_GU) { transpose_item(w_gu, DM, 2 * DFF, ((GAS bf16_t*)WSP(WS_WGU)), g_ffn, scr, r, lane, MapGU{}); continue; } r -= I_GU;
                transpose_item(w_down, DFF, DM, ((GAS bf16_t*)WSP(WS_WDOWN)), nullptr, scr, r, lane, MapId{0});
            }
            if (l == 0) {
                for (int m = gw; m < MT; m += NGW) { const GAS f32x4* xr = (const GAS f32x4*)(PTRF(0) + (size_t)m * DM) + lane; f32x4 v[4]; float s = 0.f;
#pragma unroll
                    for (int j = 0; j < 4; ++j) { v[j] = xr[64 * j]; s += (v[j][0] * v[j][0] + v[j][1] * v[j][1]) + (v[j][2] * v[j][2] + v[j][3] * v[j][3]); }
                    s = att::wave_sum(s);
                    GAS unsigned long long* o8 = (GAS unsigned long long*)(((GAS bf16_t*)WSP(WS_XB)) + (size_t)m * DM) + lane;
#pragma unroll
                    for (int j = 0; j < 4; ++j) o8[64 * j] = (unsigned long long)pk2(v[j][0], v[j][1]) | ((unsigned long long)pk2(v[j][2], v[j][3]) << 32);
                    if (lane < 16) ((GAS float*)WSP(WS_ROWSS))[(size_t)m * 16 + lane] = (lane == 0) ? s : 0.f;
                    if (lane == 0) ((GAS float*)WSP(WS_RS1))[m] = __builtin_amdgcn_rsqf(s * (1.0f / 1024.0f) + 1e-6f); }
            } else {
                for (int m = gw * 64 + lane; m < MT; m += NGW * 64) ((GAS float*)WSP(WS_RS1))[m] = pg8::row_rs((const GAS float*)WSP(WS_ROWSS), m);
            }
        }
        SEAM(P + 0);
        for (int xs_ = 0; xs_ < EXTRA_SYNC; ++xs_) grid.sync();
        if (IN(P + 1))
_Pragma("unroll 1")
        for (int rep_ = 0; rep_ < REP_G1; ++rep_) {
            int bid = blockIdx.x, Gl = gridDim.x; asm volatile("" : "+s"(bid), "+s"(Gl));
            pg8::Gemm g{((GAS bf16_t*)WSP(WS_XB)), ((GAS bf16_t*)WSP(WS_WIN)), MT, NIN, DM}; pg8::StaticOrder S; S.init(MT, NIN, Gl, bid);
            pg8::EpiQKVG E{pg8::EpiQKV{((GAS bf16_t*)WSP(WS_QKV)), ((GAS float*)WSP(WS_ROWSS)), ((GAS float*)WSP(WS_SS)), ((const GAS float*)WSP(WS_RS1))}, (GAS bf16_t*)OUTP, (GAS bf16_t*)WSP(WS_G2), PTRF(3) + (size_t)l * NGATE};
            pg8::gemm_phase<pg8::EpiQKVG, pg8::StaticOrder, true, true>(lds, g, S, E);
        }
        SEAM(P + 1);
        if (IN(P + 2))
_Pragma("unroll 1")
        for (int rep_ = 0; rep_ < REP_ATT; ++rep_) {
            int bid = blockIdx.x, Gl = gridDim.x; asm volatile("" : "+s"(bid), "+s"(Gl));
            att::AttnArgs A{((GAS bf16_t*)WSP(WS_QKV)), ((GAS bf16_t*)WSP(rep_ + 1 < REP_ATT ? WS_MERGED : WS_QKV)), ((GAS float*)WSP(WS_SS)), PTRF(4) + (size_t)l * 128, PTRF(5) + (size_t)l * 256, PTRF(6) + (size_t)l * 128, PTRF(7) + (size_t)l * 128, PTRF(8) + (size_t)l * 8 * 257, 0.8f - 0.6f * __expf(-0.3f * (float)l)};
            att::attn_phase(A, ((GAS unsigned*)WSP(WS_CTL)) + 8192 + 512 * (l + 4 * rep_), lds);
            if (rep_ + 1 < REP_ATT) grid.sync();
        }
        SEAM(P + 2);
        if (IN(P + 4))
_Pragma("unroll 1")
        for (int rep_ = 0; rep_ < REP_G2; ++rep_) {
            int bid = blockIdx.x, Gl = gridDim.x; asm volatile("" : "+s"(bid), "+s"(Gl));
            pg8::Gemm g{((GAS bf16_t*)WSP(WS_QKV)), ((GAS bf16_t*)WSP(WS_WB)), 3 * MT, 3 * DM, 512}; const int vcu = (Gl % 8 == 0) ? (bid % 8) * (Gl / 8) + bid / 8 : bid; pg8::BranchOrder S{Gl, vcu};
            pg8::EpiBranch E{(const GAS bf16_t*)OUTP, (const GAS bf16_t*)WSP(WS_G2), ((GAS bf16_t*)WSP(WS_MERGED))};
            pg8::gemm_phase<pg8::EpiBranch, pg8::BranchOrder, true, true>(lds, g, S, E);
        }
        SEAM(P + 4);
        if (IN(P + 5))
_Pragma("unroll 1")
        for (int rep_ = 0; rep_ < REP_G3; ++rep_) {
            int bid = blockIdx.x, Gl = gridDim.x; asm volatile("" : "+s"(bid), "+s"(Gl));
            pg8::Gemm g{((GAS bf16_t*)WSP(WS_MERGED)), ((GAS bf16_t*)WSP(WS_WOUT)), MT, DM, DM}; pg8::StaticOrder S; S.init(MT, DM, Gl, bid);
            pg8::EpiResid E{(GAS float*)nullptr, ((GAS bf16_t*)WSP(WS_XB)), ((GAS float*)WSP(WS_ROWSS))};
            pg8::gemm_phase<pg8::EpiResid, pg8::StaticOrder, true, true>(lds, g, S, E);
        }
        SEAM(P + 5);
        if (IN(P + 6))
_Pragma("unroll 1")
        for (int rep_ = 0; rep_ < REP_G4; ++rep_) {
            int bid = blockIdx.x, Gl = gridDim.x; asm volatile("" : "+s"(bid), "+s"(Gl));
            pg8::Gemm g{((GAS bf16_t*)WSP(WS_XB)), ((GAS bf16_t*)WSP(WS_WGU)), MT, 2 * DFF, DM}; pg8::StaticOrder S; S.init(MT, 2 * DFF, Gl, bid);
            pg8::EpiSwiGLU E{((GAS bf16_t*)WSP(WS_ACT)), ((GAS float*)WSP(WS_ROWSS))};
            pg8::gemm_phase<pg8::EpiSwiGLU, pg8::StaticOrder, true, true>(lds, g, S, E);
        }
        SEAM(P + 6);
        if (IN(P + 7))
_Pragma("unroll 1")
        for (int rep_ = 0; rep_ < REP_G5; ++rep_) {
            int bid = blockIdx.x, Gl = gridDim.x; asm volatile("" : "+s"(bid), "+s"(Gl));
            pg8::Gemm g{((GAS bf16_t*)WSP(WS_ACT)), ((GAS bf16_t*)WSP(WS_WDOWN)), MT, DM, DFF}; pg8::StaticOrder S; S.init(MT, DM, Gl, bid);
            pg8::EpiResid E{(l == DEPTH - 1) ? OUTP : (GAS float*)nullptr, ((GAS bf16_t*)WSP(WS_XB)), ((GAS float*)WSP(WS_ROWSS))};
            pg8::gemm_phase<pg8::EpiResid, pg8::StaticOrder, true, true>(lds, g, S, E);
        }
        SEAM(P + 7);
    }
#undef IN
#undef SEAM
}

#ifndef MK_SPLIT
#define MK_SPLIT 0
#endif
extern "C" void kernel_launch(void* const* d_in, const int* in_sizes, int n_in, void* d_out, int out_size, void* d_ws, size_t ws_size, hipStream_t stream) {
    static int grid = 0;
    if (grid == 0) {
        if (n_in != 16 || in_sizes[0] != MT * DM || out_size != MT * DM || ws_size < WS_END) { fprintf(stderr, "kernel_launch: unexpected shapes / workspace (n_in %d, ws %zu); nothing launched\n", n_in, ws_size); grid = -1; return; }
        int dev = 0, cus = 0, per_cu = 0;
        if (hipGetDevice(&dev) != hipSuccess || hipDeviceGetAttribute(&cus, hipDeviceAttributeMultiprocessorCount, dev) != hipSuccess) { grid = -1; return; }
        if (hipFuncSetAttribute((const void*)fwd_kernel, hipFuncAttributeMaxDynamicSharedMemorySize, LDS_BYTES) != hipSuccess) { fprintf(stderr, "kernel_launch: hipFuncSetAttribute failed\n"); grid = -1; return; }
        if (hipOccupancyMaxActiveBlocksPerMultiprocessor(&per_cu, (const void*)fwd_kernel, NWAVES * 64, LDS_BYTES) != hipSuccess || per_cu < 1) { fprintf(stderr, "kernel_launch: occupancy query says %d blocks per CU\n", per_cu); per_cu = 1; }
        (void)hipGetLastError();
        grid = cus;
    }
    if (grid < 0) return;
    (void)hipMemsetAsync((char*)d_ws + WS_CTL, 0, CTL_BYTES, stream);
    Args a{};
    for (int i = 0; i < 16; ++i) a.in[i] = (const GAS float*)d_in[i];
    a.out = (GAS float*)d_out; a.ws = (unsigned char*)d_ws;
#if MK_SPLIT
    for (int p = 0; p < 8 * DEPTH; ++p) { a.ph_lo = p; a.ph_hi = p + 1; hipLaunchKernelGGL(fwd_kernel, dim3(grid), dim3(NWAVES * 64), LDS_BYTES, stream, a); }
#else
    a.ph_lo = 0; a.ph_hi = 8 * DEPTH;
    void* kargs[] = {&a};
    hipError_t e = hipLaunchCooperativeKernel((const void*)fwd_kernel, dim3(grid), dim3(NWAVES * 64), kargs, LDS_BYTES, stream);
    if (e != hipSuccess) fprintf(stderr, "kernel_launch: cooperative launch failed: %s (grid %d)\n", hipGetErrorString(e), grid);
#endif
}
```

```cpp
#include <hip/hip_runtime.h>
#include <hip/hip_cooperative_groups.h>
#include <cstdio>
#include <cstdint>
namespace cg = cooperative_groups;
#define GAS __attribute__((address_space(1)))
namespace pg8 {
#define PG8_LAS __attribute__((address_space(3)))
typedef unsigned short bf16_t;
typedef short bf16x8 __attribute__((ext_vector_type(8)));
typedef float f32x4 __attribute__((ext_vector_type(4)));
typedef unsigned u32x4 __attribute__((ext_vector_type(4)));
constexpr int BM = 256, BK = 64, HALF = 128, HTB = HALF * BK * 2  , STAGE_BYTES = 8 * HTB, NXCD = 8, WGM = 4;

__host__ __device__ __forceinline__ int lds_byte(int r, int c) { const int st = (r >> 4) * 2 + (c >> 5), rr = r & 15, cc = c & 31, ob = rr * 64 + cc * 2; return st * 1024 + (ob ^ (((ob >> 9) & 1) << 5)); }
__host__ __device__ __forceinline__ void stage_rc(int b, int& R, int& C) { const int st = b / 1024, sb = b % 1024, swz = sb ^ (((sb >> 9) & 1) << 5); R = (st >> 1) * 16 + swz / 64; C = (st & 1) * 32 + (swz % 64) / 2; }
__host__ __device__ __forceinline__ int perm32(int rho) { const int n = rho >> 4, i = rho & 15; return 8 * (i >> 2) + 4 * n + (i & 3); }

struct Unit { int pm, pn; };
struct Gemm { const __attribute__((address_space(1))) bf16_t* A; const __attribute__((address_space(1))) bf16_t* Bt; int M, N, K; };

struct StaticOrder {
    int nM, nN, nwg, G, c;
    __host__ __device__ void init(int M, int N, int G_, int c_) { nM = M / BM; nN = N / BM; nwg = nM * nN; G = G_; c = c_; }
    __host__ __device__ bool next(int i, Unit& u) const {
        const long L = (long)i * G + c; if (L >= nwg) return false;
        int wgid = (int)L; { const int q = nwg / NXCD, r = nwg % NXCD, xcd = wgid % NXCD, off = wgid / NXCD; wgid = (xcd < r ? xcd * (q + 1) : r * (q + 1) + (xcd - r) * q) + off; }
        const int nig = WGM * nN, gid = wgid / nig, fm = gid * WGM, gsz = (nM - fm) < WGM ? (nM - fm) : WGM;
        u.pm = fm + ((wgid % nig) % gsz); u.pn = (wgid % nig) / gsz; return true;
    }
    __device__ __forceinline__ void a_ready(const Unit&) const {}
    __device__ __forceinline__ void done(const Unit&) const {}
};

typedef float f32x2 __attribute__((ext_vector_type(2)));
typedef __bf16 bf16x2_t __attribute__((ext_vector_type(2)));
typedef unsigned u32x2 __attribute__((ext_vector_type(2)));
__device__ __forceinline__ unsigned cvt_pk_bf16(float lo, float hi) { f32x2 v = {lo, hi}; bf16x2_t b = __builtin_convertvector(v, bf16x2_t); return __builtin_bit_cast(unsigned, b); }
__device__ __forceinline__ float bf_lo(unsigned u) { return __uint_as_float(u << 16); }
__device__ __forceinline__ float bf_hi(unsigned u) { return __uint_as_float(u & 0xffff0000u); }
constexpr int MROWS = 32768;
constexpr float LOG2E = 1.4426950408889634f;
__device__ __forceinline__ float sigmoid_f(float x) { return __builtin_amdgcn_rcpf(1.0f + __builtin_amdgcn_exp2f(-x * LOG2E)); }
__device__ __forceinline__ float row_rs(const GAS float* rowss, int row) {
    const GAS f32x4* p = (const GAS f32x4*)(rowss + (size_t)row * 16); const f32x4 a = p[0], b = p[1], c = p[2], d = p[3];
    const float s = ((a[0] + a[1]) + (a[2] + a[3])) + ((b[0] + b[1]) + (b[2] + b[3])) + ((c[0] + c[1]) + (c[2] + c[3])) + ((d[0] + d[1]) + (d[2] + d[3]));
    return __builtin_amdgcn_rsqf(s * (1.0f / 1024.0f) + 1e-6f);
}
struct EpiQKV {
    static constexpr bool PERM = true, AFTER_DRAIN = false, CHAIN = false;
    GAS bf16_t* QKV; const GAS float* rowss; GAS float* ss; const GAS float* rs1;
    __device__ __forceinline__ void operator()(const f32x4 (&acc)[2][2][4][2], const Unit& u, int wr, int wc, int fr, int fq) const {
        const int row0 = u.pm * BM + wr * 64 + fr; const int t = u.pn >> 1, colt = (u.pn & 1) * 256;
        GAS bf16_t* base = QKV + (size_t)t * MROWS * 512; const int col0 = colt + wc * 32 + 8 * fq;
        const int sidx = (t == 1) ? 0 : (t == 2) ? 1 : (t == 5) ? 2 : (t == 7) ? 3 : -1;
#pragma unroll
        for (int ai = 0; ai < 2; ++ai)
#pragma unroll
            for (int m = 0; m < 4; ++m) { const int row = row0 + ai * HALF + m * 16; const float rs = rs1[row]; GAS bf16_t* rowp = base + (size_t)row * 512 + col0;
#pragma unroll
                for (int bj = 0; bj < 2; ++bj) { const f32x4 v0 = acc[ai][bj][m][0] * rs, v1 = acc[ai][bj][m][1] * rs;
                    u32x4 w; w.x = cvt_pk_bf16(v0[0], v0[1]); w.y = cvt_pk_bf16(v0[2], v0[3]); w.z = cvt_pk_bf16(v1[0], v1[1]); w.w = cvt_pk_bf16(v1[2], v1[3]);
                    *(GAS u32x4*)(rowp + bj * HALF) = w;
                    if (sidx >= 0) { float q = ((v0[0] * v0[0] + v0[1] * v0[1]) + (v0[2] * v0[2] + v0[3] * v0[3])) + ((v1[0] * v1[0] + v1[1] * v1[1]) + (v1[2] * v1[2] + v1[3] * v1[3]));
                        q += __shfl_xor(q, 16); q += __shfl_xor(q, 32);
                        if (fq == 0) ss[((size_t)sidx * MROWS + row) * 16 + (colt >> 5) + 4 * bj + wc] = q; } } }
    }
};
struct EpiQKVG {
    static constexpr bool PERM = true, AFTER_DRAIN = false, CHAIN = false;
    EpiQKV q; GAS bf16_t* g01; GAS bf16_t* g2; const GAS float* bias;
    __device__ __forceinline__ void operator()(const f32x4 (&acc)[2][2][4][2], const Unit& u, int wr, int wc, int fr, int fq) const {
        if (u.pn < 18) { q(acc, u, wr, wc, fr, fq); return; }
        const int c = u.pn - 18, br = c >> 2; GAS bf16_t* G = (br < 2) ? g01 + (size_t)br * MROWS * 1024 : g2;
        const int row0 = u.pm * BM + wr * 64 + fr; const int col0 = (c & 3) * BM + wc * 32 + 8 * fq;
        f32x4 bv[2][2];
#pragma unroll
        for (int bj = 0; bj < 2; ++bj)
#pragma unroll
            for (int n = 0; n < 2; ++n) bv[bj][n] = *(const GAS f32x4*)(bias + br * 1024 + col0 + bj * HALF + 4 * n);
#pragma unroll
        for (int ai = 0; ai < 2; ++ai)
#pragma unroll
            for (int m = 0; m < 4; ++m) { const int row = row0 + ai * HALF + m * 16; const float rs = q.rs1[row]; GAS bf16_t* rowp = G + (size_t)row * 1024 + col0;
#pragma unroll
                for (int bj = 0; bj < 2; ++bj) { const f32x4 v0 = acc[ai][bj][m][0] * rs + bv[bj][0], v1 = acc[ai][bj][m][1] * rs + bv[bj][1];
                    u32x4 w; w.x = cvt_pk_bf16(fmaxf(sigmoid_f(v0[0]), 1e-30f), fmaxf(sigmoid_f(v0[1]), 1e-30f)); w.y = cvt_pk_bf16(fmaxf(sigmoid_f(v0[2]), 1e-30f), fmaxf(sigmoid_f(v0[3]), 1e-30f));
                    w.z = cvt_pk_bf16(fmaxf(sigmoid_f(v1[0]), 1e-30f), fmaxf(sigmoid_f(v1[1]), 1e-30f)); w.w = cvt_pk_bf16(fmaxf(sigmoid_f(v1[2]), 1e-30f), fmaxf(sigmoid_f(v1[3]), 1e-30f));
                    *(GAS u32x4*)(rowp + bj * HALF) = w; } }
    }
};
struct EpiBranch {
    static constexpr bool PERM = true, AFTER_DRAIN = false, CHAIN = true;
    const GAS bf16_t* g01; const GAS bf16_t* g2; GAS bf16_t* Mg;
    __device__ __forceinline__ bool keep(const Unit& u) const { return (u.pm >> 7) < 2; }
    __device__ __forceinline__ void operator()(f32x4 (&acc)[2][2][4][2], const Unit& u, int wr, int wc, int fr, int fq) const {
        const int br = u.pm >> 7, pm = u.pm & 127, pn = u.pn & 3;
        const int row0 = pm * BM + wr * 64 + fr; const int col0 = pn * BM + wc * 32 + 8 * fq;
#pragma unroll
        for (int ai = 0; ai < 2; ++ai)
#pragma unroll
            for (int m = 0; m < 4; ++m) { const int row = row0 + ai * HALF + m * 16; const GAS bf16_t* gp = ((br < 2) ? g01 + (size_t)br * MROWS * 1024 : g2) + (size_t)row * 1024 + col0; const GAS bf16_t* gn = ((br == 0) ? g01 + (size_t)MROWS * 1024 : g2) + (size_t)row * 1024 + col0; GAS bf16_t* mp = Mg + (size_t)row * 1024 + col0;
#pragma unroll
                for (int bj = 0; bj < 2; ++bj) { const u32x4 g = *(const GAS u32x4*)(gp + bj * HALF);
                    f32x4 s0 = {bf_lo(g.x), bf_hi(g.x), bf_lo(g.y), bf_hi(g.y)}, s1 = {bf_lo(g.z), bf_hi(g.z), bf_lo(g.w), bf_hi(g.w)};
                    if (br < 2) { const u32x4 h = *(const GAS u32x4*)(gn + bj * HALF);
                        const f32x4 d0 = {bf_lo(h.x), bf_hi(h.x), bf_lo(h.y), bf_hi(h.y)}, d1 = {bf_lo(h.z), bf_hi(h.z), bf_lo(h.w), bf_hi(h.w)};
#pragma unroll
                        for (int e = 0; e < 4; ++e) { s0[e] *= __builtin_amdgcn_rcpf(fmaxf(d0[e], 1e-30f)); s1[e] *= __builtin_amdgcn_rcpf(fmaxf(d1[e], 1e-30f)); }
                        acc[ai][bj][m][0] *= s0; acc[ai][bj][m][1] *= s1;
                    } else { const f32x4 v0 = acc[ai][bj][m][0] * s0, v1 = acc[ai][bj][m][1] * s1;
                        u32x4 w; w.x = cvt_pk_bf16(v0[0], v0[1]); w.y = cvt_pk_bf16(v0[2], v0[3]); w.z = cvt_pk_bf16(v1[0], v1[1]); w.w = cvt_pk_bf16(v1[2], v1[3]);
                        *(GAS u32x4*)(mp + bj * HALF) = w; } } }
    }
};
struct GateOrder {
    int G, c;
    __device__ bool next(int i, Unit& u) const { const int j = i / 3, br = i - 3 * j; const int pmn = c + j * G; if (pmn >= 512) return false; u.pm = pmn >> 2; u.pn = br * 4 + (pmn & 3); return true; }
    __device__ __forceinline__ void a_ready(const Unit&) const {}
    __device__ __forceinline__ void done(const Unit&) const {}
};
struct BranchOrder {
    int G, c;
    __device__ bool next(int i, Unit& u) const { const int j = i / 3, br = i - 3 * j; const int pmn = c + j * G; if (pmn >= 512) return false; u.pm = br * 128 + (pmn >> 2); u.pn = br * 4 + (pmn & 3); return true; }
    __device__ __forceinline__ void a_ready(const Unit&) const {}
    __device__ __forceinline__ void done(const Unit&) const {}
};
struct EpiResid {
    static constexpr bool PERM = true, AFTER_DRAIN = false, CHAIN = false;
    GAS float* out; GAS bf16_t* xb; GAS float* rowss;
    __device__ __forceinline__ void operator()(const f32x4 (&acc)[2][2][4][2], const Unit& u, int wr, int wc, int fr, int fq) const {
        const int row0 = u.pm * BM + wr * 64 + fr; const int col0 = u.pn * BM + wc * 32 + 8 * fq;
#pragma unroll
        for (int ai = 0; ai < 2; ++ai)
#pragma unroll
            for (int m = 0; m < 4; ++m) { const int row = row0 + ai * HALF + m * 16; const size_t off = (size_t)row * 1024 + col0; float q = 0.f;
#pragma unroll
                for (int bj = 0; bj < 2; ++bj) { const u32x4 xo = *(const GAS u32x4*)(xb + off + bj * HALF);
                    f32x4 v0 = acc[ai][bj][m][0], v1 = acc[ai][bj][m][1];
                    v0[0] += bf_lo(xo.x); v0[1] += bf_hi(xo.x); v0[2] += bf_lo(xo.y); v0[3] += bf_hi(xo.y); v1[0] += bf_lo(xo.z); v1[1] += bf_hi(xo.z); v1[2] += bf_lo(xo.w); v1[3] += bf_hi(xo.w);
                    if (out) { *(GAS f32x4*)(out + off + bj * HALF) = v0; *(GAS f32x4*)(out + off + bj * HALF + 4) = v1; }
                    u32x4 w; w.x = cvt_pk_bf16(v0[0], v0[1]); w.y = cvt_pk_bf16(v0[2], v0[3]); w.z = cvt_pk_bf16(v1[0], v1[1]); w.w = cvt_pk_bf16(v1[2], v1[3]);
                    if (!out) *(GAS u32x4*)(xb + off + bj * HALF) = w;
                    q += ((v0[0] * v0[0] + v0[1] * v0[1]) + (v0[2] * v0[2] + v0[3] * v0[3])) + ((v1[0] * v1[0] + v1[1] * v1[1]) + (v1[2] * v1[2] + v1[3] * v1[3])); }
                q += __shfl_xor(q, 16); q += __shfl_xor(q, 32);
                if (fq == 0 && !out) rowss[(size_t)row * 16 + u.pn * 4 + wc] = q; }
    }
};
struct EpiSwiGLU {
    static constexpr bool PERM = true, AFTER_DRAIN = false, CHAIN = false;
    GAS bf16_t* H; const GAS float* rowss;
    __device__ __forceinline__ void operator()(const f32x4 (&acc)[2][2][4][2], const Unit& u, int wr, int wc, int fr, int fq) const {
        const int row0 = u.pm * BM + wr * 64 + fr; const int col0 = (u.pn * BM + wc * 32 + 8 * fq) >> 1;
#pragma unroll
        for (int ai = 0; ai < 2; ++ai)
#pragma unroll
            for (int m = 0; m < 4; ++m) { const int row = row0 + ai * HALF + m * 16; const float rs = row_rs(rowss, row); GAS bf16_t* rowp = H + (size_t)row * 2816 + col0;
#pragma unroll
                for (int bj = 0; bj < 2; ++bj) { const f32x4 g = acc[ai][bj][m][0] * rs, uu = acc[ai][bj][m][1] * rs;
                    u32x2 w; w.x = cvt_pk_bf16(g[0] * sigmoid_f(g[0]) * uu[0], g[1] * sigmoid_f(g[1]) * uu[1]); w.y = cvt_pk_bf16(g[2] * sigmoid_f(g[2]) * uu[2], g[3] * sigmoid_f(g[3]) * uu[3]);
                    *(GAS u32x2*)(rowp + bj * (HALF / 2)) = w; } }
    }
};

template <class Epi, class Sched, bool ALIGN_EPI = false, bool SP2 = false>
__device__ __forceinline__ void gemm_phase(PG8_LAS unsigned char* lds, const Gemm g, const Sched& S, const Epi& E) {
    int tid_ = threadIdx.x; asm volatile("" : "+v"(tid_));
    const int tid = tid_, wid = __builtin_amdgcn_readfirstlane(tid >> 6), lane = tid & 63, wr = wid >> 2, wc = wid & 3, fr = lane & 15, fq = lane >> 4;
    const int K = g.K, nt = K / BK;
    unsigned voffA[2], voffB[2];
#pragma unroll
    for (int i = 0; i < 2; ++i) { int R, C; stage_rc(tid * 16 + i * 8192, R, C); const int Rb = Epi::PERM ? ((R & ~31) + perm32(R & 31)) : R;
        voffA[i] = (unsigned)(R * K + C) * 2u; voffB[i] = (unsigned)(Rb * K + C) * 2u; }
    const size_t kstep = (size_t)(BK * 2);
    const size_t hstep = (size_t)HALF * K * 2;
    const size_t tstep = 2 * hstep;
    const unsigned ldsw = (unsigned)wid * 1024u;
    const int aoff = lds_byte(wr * 64 + fr, fq * 8), boff = lds_byte(wc * 32 + fr, fq * 8);
#define PG8_SA(b, h) (((b) * 2 + (h)) * HTB)
#define PG8_SB(b, h) ((4 + (b) * 2 + (h)) * HTB)
#define PG8_STAGE(bufoff, gbase, voff) do { _Pragma("unroll") for (int _i = 0; _i < 2; ++_i) \
        __builtin_amdgcn_global_load_lds((const unsigned*)((const char*)(gbase) + (voff)[_i]), (PG8_LAS unsigned*)(lds + (bufoff) + ldsw + _i * 8192), 16, 0, 0); } while (0)
#define PG8_LDA(dst, b, h) do { _Pragma("unroll") for (int m = 0; m < 4; ++m) _Pragma("unroll") for (int k = 0; k < 2; ++k) dst[m][k] = *(const PG8_LAS bf16x8*)(lds + PG8_SA(b, h) + aoff + m * 2048 + k * 1024); } while (0)
#define PG8_LDB(dst, b, h) do { _Pragma("unroll") for (int n = 0; n < 2; ++n) _Pragma("unroll") for (int k = 0; k < 2; ++k) dst[n][k] = *(const PG8_LAS bf16x8*)(lds + PG8_SB(b, h) + boff + n * 2048 + k * 1024); } while (0)
#define PG8_MMA(ai, bj, At, Bt) do { __builtin_amdgcn_s_setprio(1); _Pragma("unroll") for (int m = 0; m < 4; ++m) _Pragma("unroll") for (int n = 0; n < 2; ++n) _Pragma("unroll") for (int k = 0; k < 2; ++k) \
        acc[ai][bj][m][n] = __builtin_amdgcn_mfma_f32_16x16x32_bf16(Bt[n][k], At[m][k], acc[ai][bj][m][n], 0, 0, 0); __builtin_amdgcn_s_setprio(0); } while (0)
#define PG8_WAIT_V(n) asm volatile("s_waitcnt vmcnt(" #n ")" ::: "memory")
#define PG8_WAIT_L(n) asm volatile("s_waitcnt lgkmcnt(" #n ")" ::: "memory")
#define PG8_BAR __builtin_amdgcn_s_barrier()
#define PG8_SCHED __builtin_amdgcn_sched_barrier(0)
    Unit cur, nxt; int ui = 0;
    if (!S.next(0, cur)) return;
    f32x4 acc[2][2][4][2];
#pragma unroll
    for (int a = 0; a < 2; ++a)
#pragma unroll
        for (int b = 0; b < 2; ++b)
#pragma unroll
            for (int m = 0; m < 4; ++m)
#pragma unroll
                for (int n = 0; n < 2; ++n) acc[a][b][m][n] = (f32x4){0.f, 0.f, 0.f, 0.f};
    bf16x8 At[4][2], B0[2][2], B1[2][2];
    const char* cA = (const char*)g.A + (size_t)cur.pm * tstep; const char* cB = (const char*)g.Bt + (size_t)cur.pn * tstep;
    S.a_ready(cur);
    if constexpr (SP2) {
        PG8_STAGE(PG8_SB(0, 0), cB, voffB); PG8_STAGE(PG8_SB(0, 1), cB + hstep, voffB); PG8_STAGE(PG8_SA(0, 0), cA, voffA); PG8_STAGE(PG8_SA(0, 1), cA + hstep, voffA);
        if (wr == 1) PG8_BAR;
        PG8_WAIT_V(2); PG8_BAR;
        PG8_STAGE(PG8_SB(1, 0), cB + kstep, voffB); PG8_STAGE(PG8_SA(1, 0), cA + kstep, voffA); PG8_STAGE(PG8_SB(1, 1), cB + hstep + kstep, voffB);
        PG8_WAIT_V(6); PG8_BAR;
    } else {
        PG8_STAGE(PG8_SB(0, 0), cB, voffB); PG8_STAGE(PG8_SA(0, 0), cA, voffA); PG8_STAGE(PG8_SB(0, 1), cB + hstep, voffB); PG8_STAGE(PG8_SA(0, 1), cA + hstep, voffA);
        if (wr == 1) PG8_BAR;
        PG8_WAIT_V(4); PG8_BAR;
        PG8_STAGE(PG8_SB(1, 0), cB + kstep, voffB); PG8_STAGE(PG8_SA(1, 0), cA + kstep, voffA); PG8_STAGE(PG8_SB(1, 1), cB + hstep + kstep, voffB);
        PG8_WAIT_V(6); PG8_BAR;
    }
    for (;;) {
        const bool has_next = S.next(ui + 1, nxt);
        const char* nA = has_next ? (const char*)g.A + (size_t)nxt.pm * tstep : cA; const char* nB = has_next ? (const char*)g.Bt + (size_t)nxt.pn * tstep : cB;
        for (int t = 0; t < nt; t += 2) {
            const bool last = (t == nt - 2);
            const char* a1 = cA + (size_t)(t + 1) * kstep;
            const char* a2 = last ? nA : cA + (size_t)(t + 2) * kstep; const char* b2 = last ? nB : cB + (size_t)(t + 2) * kstep;
            const char* a3 = a2 + kstep; const char* b3 = b2 + kstep;
            if (last && has_next) S.a_ready(nxt);
            if constexpr (SP2) {
            PG8_LDB(B0, 0, 0); PG8_LDB(B1, 0, 1); PG8_SCHED; PG8_LDA(At, 0, 0); PG8_STAGE(PG8_SA(1, 1), a1 + hstep, voffA);
            PG8_WAIT_V(8); PG8_WAIT_L(0); PG8_BAR; PG8_MMA(0, 0, At, B0); PG8_MMA(0, 1, At, B1); PG8_BAR; PG8_SCHED;
            PG8_LDA(At, 0, 1); PG8_STAGE(PG8_SB(0, 0), b2, voffB); PG8_STAGE(PG8_SB(0, 1), b2 + hstep, voffB); PG8_STAGE(PG8_SA(0, 0), a2, voffA);
            PG8_WAIT_V(8); PG8_WAIT_L(0); PG8_BAR; PG8_MMA(1, 0, At, B0); PG8_MMA(1, 1, At, B1); PG8_BAR; PG8_SCHED;
            PG8_LDB(B0, 1, 0); PG8_LDB(B1, 1, 1); PG8_SCHED; PG8_LDA(At, 1, 0); PG8_STAGE(PG8_SA(0, 1), a2 + hstep, voffA);
            PG8_WAIT_V(8); PG8_WAIT_L(0); PG8_BAR; PG8_MMA(0, 0, At, B0); PG8_MMA(0, 1, At, B1); PG8_BAR; PG8_SCHED;
            PG8_LDA(At, 1, 1); PG8_STAGE(PG8_SB(1, 0), b3, voffB); PG8_STAGE(PG8_SB(1, 1), b3 + hstep, voffB); PG8_STAGE(PG8_SA(1, 0), a3, voffA);
            PG8_WAIT_V(8); PG8_WAIT_L(0); PG8_BAR; PG8_MMA(1, 0, At, B0); PG8_MMA(1, 1, At, B1); PG8_BAR; PG8_SCHED;
            } else {
            PG8_LDB(B0, 0, 0); PG8_SCHED; PG8_LDA(At, 0, 0); PG8_STAGE(PG8_SA(1, 1), a1 + hstep, voffA);
            PG8_WAIT_L(8); PG8_BAR; PG8_WAIT_L(0); PG8_MMA(0, 0, At, B0); PG8_BAR; PG8_SCHED;
            PG8_LDB(B1, 0, 1); PG8_STAGE(PG8_SB(0, 0), b2, voffB);
            PG8_BAR; PG8_WAIT_L(0); PG8_MMA(0, 1, At, B1); PG8_BAR;
            PG8_LDA(At, 0, 1); PG8_STAGE(PG8_SA(0, 0), a2, voffA);
            PG8_BAR; PG8_WAIT_L(0); PG8_MMA(1, 0, At, B0); PG8_BAR; PG8_SCHED;
            PG8_STAGE(PG8_SB(0, 1), b2 + hstep, voffB);
            PG8_WAIT_V(6); PG8_BAR; PG8_MMA(1, 1, At, B1); PG8_BAR;
            PG8_LDB(B0, 1, 0); PG8_SCHED; PG8_LDA(At, 1, 0); PG8_STAGE(PG8_SA(0, 1), a2 + hstep, voffA);
            PG8_WAIT_L(8); PG8_BAR; PG8_WAIT_L(0); PG8_MMA(0, 0, At, B0); PG8_BAR; PG8_SCHED;
            PG8_LDB(B1, 1, 1); PG8_STAGE(PG8_SB(1, 0), b3, voffB);
            PG8_BAR; PG8_WAIT_L(0); PG8_MMA(0, 1, At, B1); PG8_BAR;
            PG8_LDA(At, 1, 1); PG8_STAGE(PG8_SA(1, 0), a3, voffA);
            PG8_BAR; PG8_WAIT_L(0); PG8_MMA(1, 0, At, B0); PG8_BAR; PG8_SCHED;
            PG8_STAGE(PG8_SB(1, 1), b3 + hstep, voffB);
            PG8_WAIT_V(6); PG8_BAR; PG8_MMA(1, 1, At, B1); PG8_BAR;
            }
        }
        if constexpr (ALIGN_EPI) { if (wr == 0) PG8_BAR; }
        if constexpr (!Epi::AFTER_DRAIN) { E(acc, cur, wr, wc, fr, fq); S.done(cur); }
        if (!has_next) break;
        bool keep_ = false; if constexpr (Epi::CHAIN) keep_ = E.keep(cur);
        if (!keep_) {
#pragma unroll
        for (int a = 0; a < 2; ++a)
#pragma unroll
            for (int b = 0; b < 2; ++b)
#pragma unroll
                for (int m = 0; m < 4; ++m)
#pragma unroll
                    for (int n = 0; n < 2; ++n) acc[a][b][m][n] = (f32x4){0.f, 0.f, 0.f, 0.f};
        }
        cur = nxt; cA = nA; cB = nB; ++ui;
        if constexpr (ALIGN_EPI) { if (wr == 1) PG8_BAR; }
    }
    PG8_WAIT_V(0);
    if constexpr (!ALIGN_EPI) { if (wr == 0) PG8_BAR; }
    PG8_BAR;
    if constexpr (Epi::AFTER_DRAIN) { E.fused(acc, cur, wr, wc, fr, fq, lds, wid, lane); S.done(cur); }
#undef PG8_SA
#undef PG8_SB
#undef PG8_STAGE
#undef PG8_LDA
#undef PG8_LDB
#undef PG8_MMA
#undef PG8_WAIT_V
#undef PG8_WAIT_L
#undef PG8_BAR
#undef PG8_SCHED
}
}
namespace att {
#define LAS __attribute__((address_space(3)))
typedef unsigned short bf16_t;
typedef short bf16x8 __attribute__((ext_vector_type(8)));
typedef short s16x4 __attribute__((ext_vector_type(4)));
typedef short v4i16_t __attribute__((ext_vector_type(4)));
typedef float f32x16 __attribute__((ext_vector_type(16)));
typedef float f32x4 __attribute__((ext_vector_type(4)));
typedef unsigned u32x4 __attribute__((ext_vector_type(4)));
typedef unsigned u32x2 __attribute__((ext_vector_type(2)));
constexpr int SEQ = 2048, PITCH = 512, MROWS = 32768;
constexpr size_t BUF = (size_t)MROWS * 512;
constexpr float LOG2E = 1.4426950408889634f, C2 = 0.125f * LOG2E;
constexpr int TAB_OFF = 65536, BC_OFF = 131072 + 512, FL_OFF = BC_OFF + 64, PRM_OFF = 131072 + 4096;
using pg8::cvt_pk_bf16; using pg8::bf_lo; using pg8::bf_hi;
#define MFMA32(a, b, c) __builtin_amdgcn_mfma_f32_32x32x16_bf16((a), (b), (c), 0, 0, 0)
__device__ __forceinline__ s16x4 vtr(const LAS unsigned char* p) { return __builtin_bit_cast(s16x4, __builtin_amdgcn_ds_read_tr16_b64_v4i16((LAS v4i16_t*)p)); }
__device__ __forceinline__ u32x4 scale8(u32x4 v, float s) { u32x4 o; o.x = cvt_pk_bf16(bf_lo(v.x) * s, bf_hi(v.x) * s); o.y = cvt_pk_bf16(bf_lo(v.y) * s, bf_hi(v.y) * s); o.z = cvt_pk_bf16(bf_lo(v.z) * s, bf_hi(v.z) * s); o.w = cvt_pk_bf16(bf_lo(v.w) * s, bf_hi(v.w) * s); return o; }
__device__ __forceinline__ bf16x8 pack8(const f32x16& p, int s) { u32x4 w; w.x = cvt_pk_bf16(p[8 * s], p[8 * s + 1]); w.y = cvt_pk_bf16(p[8 * s + 2], p[8 * s + 3]); w.z = cvt_pk_bf16(p[8 * s + 4], p[8 * s + 5]); w.w = cvt_pk_bf16(p[8 * s + 6], p[8 * s + 7]); return __builtin_bit_cast(bf16x8, w); }
__device__ __forceinline__ float wave_sum(float v) {
#pragma unroll
    for (int o = 1; o < 64; o <<= 1) v += __shfl_xor(v, o);
    return v; }
struct AttnArgs { GAS bf16_t* qkv; GAS bf16_t* obase; const GAS float* ss; const GAS float* qk_g_diff; const GAS float* lambda_qk; const GAS float* subln_g; const GAS float* qk_g_ch; const GAS float* rel_bias; float lam_init; };

__device__ __forceinline__ void qkt(f32x16& p0, f32x16& p1, const LAS unsigned char* kimg, const bf16x8* qr, int r32, int hi, float cinit = 0.f) {
    const LAS unsigned char* kb = kimg + hi * 1024 + r32 * 16;
#pragma unroll
    for (int r = 0; r < 16; ++r) { p0[r] = cinit; p1[r] = cinit; }
    bf16x8 kf[8];
#pragma unroll
    for (int d0 = 0; d0 < 4; ++d0) { kf[2 * d0] = *(const LAS bf16x8*)(kb + d0 * 2048); kf[2 * d0 + 1] = *(const LAS bf16x8*)(kb + d0 * 2048 + 512); }
    __builtin_amdgcn_sched_barrier(0);
#pragma unroll
    for (int d0 = 0; d0 < 4; ++d0) { p0 = MFMA32(kf[2 * d0], qr[d0], p0); p1 = MFMA32(kf[2 * d0 + 1], qr[d0], p1); }
    __builtin_amdgcn_sched_barrier(0);
}
template <int NB> __device__ __forceinline__ void pv(f32x16* o, const LAS unsigned char* vimg, int vl, const f32x16& p0, const f32x16& p1) {
    const bf16x8 pf[4] = {pack8(p0, 0), pack8(p0, 1), pack8(p1, 0), pack8(p1, 1)};
    s16x4 lo[2][4], hh[2][4];
#pragma unroll
    for (int ks = 0; ks < 4; ++ks) { const LAS unsigned char* vp = vimg + vl + ks * 1024; lo[0][ks] = vtr(vp); hh[0][ks] = vtr(vp + 512); }
#pragma unroll
    for (int blk = 0; blk < NB; ++blk) {
        if (blk + 1 < NB) {
#pragma unroll
            for (int ks = 0; ks < 4; ++ks) { const LAS unsigned char* vp = vimg + vl + (blk + 1) * 4096 + ks * 1024; lo[(blk + 1) & 1][ks] = vtr(vp); hh[(blk + 1) & 1][ks] = vtr(vp + 512); } }
        __builtin_amdgcn_sched_barrier(0);
#pragma unroll
        for (int ks = 0; ks < 4; ++ks) { const s16x4 a = lo[blk & 1][ks], b = hh[blk & 1][ks];
            const bf16x8 vf = (bf16x8){a[0], a[1], a[2], a[3], b[0], b[1], b[2], b[3]};
            o[blk] = MFMA32(vf, pf[ks], o[blk]); }
        __builtin_amdgcn_sched_barrier(0);
    }
}
__device__ __forceinline__ void qkt_half(f32x16& p, const LAS unsigned char* kimg, const bf16x8* qr, int r32, int hi, float cinit, int half) {
    const LAS unsigned char* kb = kimg + hi * 1024 + r32 * 16 + half * 512;
#pragma unroll
    for (int r = 0; r < 16; ++r) p[r] = cinit;
    bf16x8 kf[4];
#pragma unroll
    for (int d0 = 0; d0 < 4; ++d0) kf[d0] = *(const LAS bf16x8*)(kb + d0 * 2048);
#pragma unroll
    for (int d0 = 0; d0 < 4; ++d0) p = MFMA32(kf[d0], qr[d0], p);
}
template <int NB> __device__ __forceinline__ void pv_half(f32x16* o, const LAS unsigned char* vimg, int vl, const f32x16& p, int half) {
    const bf16x8 pf[2] = {pack8(p, 0), pack8(p, 1)};
#pragma unroll
    for (int blk = 0; blk < NB; ++blk) { s16x4 lo[2], hh[2];
#pragma unroll
        for (int ks = 0; ks < 2; ++ks) { const LAS unsigned char* vp = vimg + vl + blk * 4096 + (2 * half + ks) * 1024; lo[ks] = vtr(vp); hh[ks] = vtr(vp + 512); }
#pragma unroll
        for (int ks = 0; ks < 2; ++ks) { const bf16x8 vf = (bf16x8){lo[ks][0], lo[ks][1], lo[ks][2], lo[ks][3], hh[ks][0], hh[ks][1], hh[ks][2], hh[ks][3]};
            o[blk] = MFMA32(vf, pf[ks], o[blk]); } }
}
template <int NB> __device__ __forceinline__ void store_o(GAS bf16_t* orow, const f32x16* o, int hi) {
#pragma unroll
    for (int blk = 0; blk < NB; ++blk)
#pragma unroll
        for (int i = 0; i < 4; ++i) { u32x2 w; w.x = cvt_pk_bf16(o[blk][4 * i], o[blk][4 * i + 1]); w.y = cvt_pk_bf16(o[blk][4 * i + 2], o[blk][4 * i + 3]);
            *(GAS u32x2*)(orow + blk * 32 + 8 * i + 4 * hi) = w; }
}

template <int VAR, bool FIX> __device__ __forceinline__ void unit_ac(const AttnArgs& A, int b, int h, int qb, LAS unsigned char* lds, float shift) {
    int tid_ = threadIdx.x; asm volatile("" : "+v"(tid_));
    const int tid = tid_, lane = tid & 63, r32 = lane & 31, hi = lane >> 5; const int wid = __builtin_amdgcn_readfirstlane(tid >> 6);
    const size_t rowbase = (size_t)b * SEQ; const int q0 = qb * 256;
    if (wid < 4) __builtin_amdgcn_s_setprio(2); else __builtin_amdgcn_s_setprio(0);
    GAS bf16_t* qkv_ = A.qkv; const GAS float* ss_ = A.ss; asm volatile("" : "+s"(qkv_), "+s"(ss_));
    GAS bf16_t* Qb = qkv_ + (VAR == 0 ? 0 : 2) * BUF; const GAS bf16_t* Kb = qkv_ + (VAR == 0 ? 3 : 7) * BUF; const GAS bf16_t* Vb = qkv_ + (VAR == 0 ? 4 : 8) * BUF;
    const GAS float* ssq = ss_ + (size_t)1 * MROWS * 16; const GAS float* ssk = ss_ + (size_t)3 * MROWS * 16;
    const int qrow = q0 + wid * 32 + r32;
    bf16x8 qr[4];
    { const GAS bf16_t* qp = Qb + (rowbase + qrow) * PITCH + h * 64; float qs = C2;
      if (VAR == 2) { const GAS float* s = ssq + (rowbase + qrow) * 16 + 2 * h; qs = C2 * __builtin_amdgcn_rsqf((s[0] + s[1]) * (1.0f / 64.0f) + 1e-6f); }
#pragma unroll
      for (int d0 = 0; d0 < 4; ++d0) { const u32x4 raw = *(const GAS u32x4*)(qp + d0 * 16 + hi * 8); u32x4 w;
          if (VAR == 2) { const LAS float* g = (const LAS float*)(lds + PRM_OFF) + 96 + d0 * 16 + hi * 8; const f32x4 a0 = *(const LAS f32x4*)g * qs, a1 = *(const LAS f32x4*)(g + 4) * qs;
              w.x = cvt_pk_bf16(bf_lo(raw.x) * a0[0], bf_hi(raw.x) * a0[1]); w.y = cvt_pk_bf16(bf_lo(raw.y) * a0[2], bf_hi(raw.y) * a0[3]);
              w.z = cvt_pk_bf16(bf_lo(raw.z) * a1[0], bf_hi(raw.z) * a1[1]); w.w = cvt_pk_bf16(bf_lo(raw.w) * a1[2], bf_hi(raw.w) * a1[3]); }
          else w = scale8(raw, qs);
          qr[d0] = __builtin_bit_cast(bf16x8, w); } }
    const int t_hi = 4 * qb + 3, t_lo = (VAR == 0) ? 0 : ((4 * qb - 8) > 0 ? (4 * qb - 8) : 0), nT = t_hi - t_lo + 1;
    const int tw = 4 * qb + (wid >> 1);
    if (VAR == 2) { LAS float* T = (LAS float*)(lds + TAB_OFF);
        for (int j = tid; j < 640; j += 512) { int d = j - 63; d = d < -128 ? -128 : (d > 128 ? 128 : d); T[j] = A.rel_bias[h * 257 + d + 128] * LOG2E; } }
    const GAS bf16_t* ksrc = Kb + (rowbase + lane) * PITCH + h * 64 + wid * 8;
    const GAS bf16_t* vsrc = Vb + (rowbase + 16 * (wid & 3) + (lane >> 2)) * PITCH + h * 64 + (wid >> 2) * 32 + (lane & 3) * 8;
    const GAS float* ksst = ssk + (rowbase + lane) * 16 + 2 * h;
    const int sdst = wid * 1024 + lane * 16;
    u32x4 kreg, vreg;
    float ks0 = 0.f, ks1 = 0.f;
#define LOAD_T(t) do { kreg = *(const GAS u32x4*)(ksrc + (size_t)(t) * 64 * PITCH); vreg = *(const GAS u32x4*)(vsrc + (size_t)(t) * 64 * PITCH); \
        if (VAR == 2) { const GAS float* s_ = ksst + (size_t)(t) * 64 * 16; ks0 = s_[0]; ks1 = s_[1]; } } while (0)
#define WRITE_T(st) do { if (VAR == 2) kreg = scale8(kreg, __builtin_amdgcn_rsqf((ks0 + ks1) * (1.0f / 64.0f) + 1e-6f)); \
        *(LAS u32x4*)(lds + (st) * 16384 + sdst) = kreg; *(LAS u32x4*)(lds + (st) * 16384 + 8192 + sdst) = vreg; } while (0)
#define TILE(i) ((VAR == 0) ? (t_hi - (i)) : (t_lo + (i)))
    const int vl = (4 * hi + ((lane & 15) >> 2)) * 64 + ((lane >> 4) & 1) * 32 + (lane & 3) * 8;
    f32x16 o[2]; o[0] = f32x16{}; o[1] = f32x16{};
    float m_run = -1e30f, l_run = 0.f, pc = 1.0f;
    LOAD_T(TILE(0)); WRITE_T(0); __syncthreads();
    for (int i = 0; i < nT; ++i) {
        const int t = TILE(i); const int st = i & 1;
        if (i + 1 < nT) LOAD_T(TILE(i + 1));
        const bool wdone = (VAR == 0) && (__builtin_amdgcn_ballot_w64(pc != 0.0f) == 0ull);
        const bool active = (VAR == 0) ? (t <= tw && !wdone) : (t <= tw && t >= tw - 8);
        if (active) {
            f32x16 p0, p1;
            if (VAR == 2 && FIX) {
                const LAS float* T = (const LAS float*)(lds + TAB_OFF);
                const bool far = (t <= tw - 3);
                const LAS unsigned char* kimg = lds + st * 16384; const LAS unsigned char* vimg = lds + st * 16384 + 8192;
                const LAS float* Tq = T + (qrow + 63 - 64 * t - 4 * hi);
                float sum0 = 0.f, sum1 = 0.f;
                if (far) {
                    const float ci = T[639] - shift;
                    qkt_half(p0, kimg, qr, r32, hi, ci, 0); qkt_half(p1, kimg, qr, r32, hi, ci, 1);
#pragma unroll
                    for (int r = 0; r < 16; ++r) { p0[r] = __builtin_amdgcn_exp2f(p0[r]); sum0 += p0[r]; }
                    pv_half<2>(o, vimg, vl, p0, 0);
#pragma unroll
                    for (int r = 0; r < 16; ++r) { p1[r] = __builtin_amdgcn_exp2f(p1[r]); sum1 += p1[r]; }
                    pv_half<2>(o, vimg, vl, p1, 1);
                } else {
                    qkt_half(p0, kimg, qr, r32, hi, -shift, 0); qkt_half(p1, kimg, qr, r32, hi, -shift, 1);
#pragma unroll
                    for (int r = 0; r < 16; ++r) { const int kk = (r & 3) + 8 * (r >> 2); p0[r] = __builtin_amdgcn_exp2f(p0[r] + Tq[-kk]); sum0 += p0[r]; }
                    pv_half<2>(o, vimg, vl, p0, 0);
#pragma unroll
                    for (int r = 0; r < 16; ++r) { const int kk = (r & 3) + 8 * (r >> 2); p1[r] = __builtin_amdgcn_exp2f(p1[r] + Tq[-kk - 32]); sum1 += p1[r]; }
                    pv_half<2>(o, vimg, vl, p1, 1);
                }
                l_run += sum0 + sum1;
            } else if (VAR == 2) {
                qkt(p0, p1, lds + st * 16384, qr, r32, hi);
                const LAS float* T = (const LAS float*)(lds + TAB_OFF) + (qrow + 63 - 64 * t - 4 * hi);
#pragma unroll
                for (int r = 0; r < 16; ++r) { const int kk = (r & 3) + 8 * (r >> 2); p0[r] += T[-kk]; p1[r] += T[-kk - 32]; }
                float mx = p0[0];
#pragma unroll
                for (int r = 1; r < 16; ++r) mx = fmaxf(mx, p0[r]);
#pragma unroll
                for (int r = 0; r < 16; ++r) mx = fmaxf(mx, p1[r]);
                mx = fmaxf(mx, __shfl_xor(mx, 32));
                const float mn = fmaxf(m_run, mx), alpha = __builtin_amdgcn_exp2f(m_run - mn); m_run = mn;
                float sum = 0.f;
#pragma unroll
                for (int r = 0; r < 16; ++r) { p0[r] = __builtin_amdgcn_exp2f(p0[r] - mn); p1[r] = __builtin_amdgcn_exp2f(p1[r] - mn); sum += p0[r] + p1[r]; }
                l_run = l_run * alpha + sum;
#pragma unroll
                for (int r = 0; r < 16; ++r) { o[0][r] *= alpha; o[1][r] *= alpha; }
            } else {
                qkt(p0, p1, lds + st * 16384, qr, r32, hi);
                const bool diag = (t == tw); const int qd = (wid & 1) * 32 + r32;
                float G[16];
#pragma unroll
                for (int p = 0; p < 2; ++p)
#pragma unroll
                    for (int i4 = 0; i4 < 4; ++i4) { float rr[4];
#pragma unroll
                        for (int j = 0; j < 4; ++j) { const float z = p ? p1[4 * i4 + j] : p0[4 * i4 + j]; float rv = __builtin_amdgcn_rcpf(1.0f + __builtin_amdgcn_exp2f(fminf(z, 80.f)));
                            if (diag) { const int kk = 32 * p + 8 * i4 + 4 * hi + j; if (kk >= qd) rv = 1.0f; }
                            rr[j] = rv; }
                        const float sc = rr[3], sb = rr[3] * rr[2], sa = sb * rr[1], R = sa * rr[0];
                        const float w0 = (1.0f - rr[0]) * sa, w1 = (1.0f - rr[1]) * sb, w2 = (1.0f - rr[2]) * sc, w3 = (1.0f - rr[3]);
                        if (p) { p1[4 * i4] = w0; p1[4 * i4 + 1] = w1; p1[4 * i4 + 2] = w2; p1[4 * i4 + 3] = w3; } else { p0[4 * i4] = w0; p0[4 * i4 + 1] = w1; p0[4 * i4 + 2] = w2; p0[4 * i4 + 3] = w3; }
                        const float Ro = __shfl_xor(R, 32);
                        G[2 * (4 * p + i4)] = hi ? Ro : R; G[2 * (4 * p + i4) + 1] = hi ? R : Ro; }
                float Ee[8], Eo[8]; Eo[7] = pc;
#pragma unroll
                for (int q = 7; q >= 0; --q) { Ee[q] = Eo[q] * G[2 * q + 1]; if (q > 0) Eo[q - 1] = Ee[q] * G[2 * q]; }
                pc = Ee[0] * G[0];
#pragma unroll
                for (int q = 0; q < 8; ++q) { const float e = hi ? Eo[q] : Ee[q];
#pragma unroll
                    for (int j = 0; j < 4; ++j) { if (q < 4) p0[4 * q + j] *= e; else p1[4 * (q - 4) + j] *= e; } }
            }
            if (!(VAR == 2 && FIX)) pv<2>(o, lds + st * 16384 + 8192, vl, p0, p1);
        }
        if (i + 1 < nT) WRITE_T(st ^ 1);
        if (VAR == 0) { const bool wd2 = (__builtin_amdgcn_ballot_w64(pc != 0.0f) == 0ull); if (lane == 0) ((LAS unsigned*)(lds + FL_OFF))[st * 8 + wid] = wd2 ? 1u : 0u; }
        __syncthreads();
        if (VAR == 0) { const LAS unsigned* fl = (const LAS unsigned*)(lds + FL_OFF) + st * 8; const unsigned all = fl[0] & fl[1] & fl[2] & fl[3] & fl[4] & fl[5] & fl[6] & fl[7];
            if (__builtin_amdgcn_readfirstlane(all)) break; }
    }
    if (VAR == 2) { const float lt = l_run + __shfl_xor(l_run, 32), inv = __builtin_amdgcn_rcpf(lt);
#pragma unroll
        for (int r = 0; r < 16; ++r) { o[0][r] *= inv; o[1][r] *= inv; } }
    store_o<2>(A.obase + (VAR == 0 ? 0 : 2) * BUF + (rowbase + qrow) * PITCH + h * 64, o, hi);
#undef LOAD_T
#undef WRITE_T
#undef TILE
}

__device__ __forceinline__ void unit_a4(const AttnArgs& A, int b, int hg, int c, LAS unsigned char* lds) {
    int tid_ = threadIdx.x; asm volatile("" : "+v"(tid_));
    const int tid = tid_, lane = tid & 63, r32 = lane & 31, hi = lane >> 5; const int wid = __builtin_amdgcn_readfirstlane(tid >> 6);
    const int hh = wid >> 1, h = 4 * hg + hh;
    const size_t rowbase = (size_t)b * SEQ;
    if (wid < 4) __builtin_amdgcn_s_setprio(2); else __builtin_amdgcn_s_setprio(0);
    GAS bf16_t* qkv_ = A.qkv; asm volatile("" : "+s"(qkv_));
    GAS bf16_t* Qb = qkv_; const GAS bf16_t* Kb = qkv_ + 3 * BUF; const GAS bf16_t* Vb = qkv_ + 4 * BUF;
    const int qd = (wid & 1) * 32 + r32, qrow = 64 * c + qd;
    bf16x8 qr[4];
    { const GAS bf16_t* qp = Qb + (rowbase + qrow) * PITCH + h * 64;
#pragma unroll
      for (int d0 = 0; d0 < 4; ++d0) qr[d0] = __builtin_bit_cast(bf16x8, scale8(*(const GAS u32x4*)(qp + d0 * 16 + hi * 8), C2)); }
    const GAS bf16_t* ksrc = Kb + (rowbase + lane) * PITCH + hg * 256 + wid * 8;
    const GAS bf16_t* vsrc = Vb + (rowbase + 16 * (wid & 3) + (lane >> 2)) * PITCH + hg * 256 + (wid >> 2) * 32 + (lane & 3) * 8;
    const int sdst = wid * 1024 + lane * 16;
    u32x4 kr[4], vr[4];
#define LOAD_T(t) do { const size_t o_ = (size_t)(t) * 64 * PITCH; _Pragma("unroll") for (int j = 0; j < 4; ++j) { kr[j] = *(const GAS u32x4*)(ksrc + o_ + j * 64); vr[j] = *(const GAS u32x4*)(vsrc + o_ + j * 64); } } while (0)
#define WRITE_T(st) do { _Pragma("unroll") for (int j = 0; j < 4; ++j) { *(LAS u32x4*)(lds + (st) * 65536 + j * 8192 + sdst) = kr[j]; *(LAS u32x4*)(lds + (st) * 65536 + 32768 + j * 8192 + sdst) = vr[j]; } } while (0)
    const int vl = (4 * hi + ((lane & 15) >> 2)) * 64 + ((lane >> 4) & 1) * 32 + (lane & 3) * 8;
    f32x16 o[2]; o[0] = f32x16{}; o[1] = f32x16{};
    float pc = 1.0f;
    const int nT = c + 1;
    LOAD_T(c); WRITE_T(0); __syncthreads();
    for (int i = 0; i < nT; ++i) {
        const int t = c - i; const int st = i & 1;
        if (i + 1 < nT) LOAD_T(t - 1);
        const bool wdone = (__builtin_amdgcn_ballot_w64(pc != 0.0f) == 0ull);
        if (!wdone) {
            f32x16 p0, p1; qkt(p0, p1, lds + st * 65536 + hh * 8192, qr, r32, hi);
            const bool diag = (i == 0);
            float G[16];
#pragma unroll
            for (int p = 0; p < 2; ++p)
#pragma unroll
                for (int i4 = 0; i4 < 4; ++i4) { float rr[4];
#pragma unroll
                    for (int j = 0; j < 4; ++j) { const float z = p ? p1[4 * i4 + j] : p0[4 * i4 + j]; float rv = __builtin_amdgcn_rcpf(1.0f + __builtin_amdgcn_exp2f(fminf(z, 80.f)));
                        if (diag) { const int kk = 32 * p + 8 * i4 + 4 * hi + j; if (kk >= qd) rv = 1.0f; }
                        rr[j] = rv; }
                    const float sc = rr[3], sb = rr[3] * rr[2], sa = sb * rr[1], R = sa * rr[0];
                    const float w0 = (1.0f - rr[0]) * sa, w1 = (1.0f - rr[1]) * sb, w2 = (1.0f - rr[2]) * sc, w3 = (1.0f - rr[3]);
                    if (p) { p1[4 * i4] = w0; p1[4 * i4 + 1] = w1; p1[4 * i4 + 2] = w2; p1[4 * i4 + 3] = w3; } else { p0[4 * i4] = w0; p0[4 * i4 + 1] = w1; p0[4 * i4 + 2] = w2; p0[4 * i4 + 3] = w3; }
                    const float Ro = __shfl_xor(R, 32);
                    G[2 * (4 * p + i4)] = hi ? Ro : R; G[2 * (4 * p + i4) + 1] = hi ? R : Ro; }
            float Ee[8], Eo[8]; Eo[7] = pc;
#pragma unroll
            for (int q = 7; q >= 0; --q) { Ee[q] = Eo[q] * G[2 * q + 1]; if (q > 0) Eo[q - 1] = Ee[q] * G[2 * q]; }
            pc = Ee[0] * G[0];
#pragma unroll
            for (int q = 0; q < 8; ++q) { const float e = hi ? Eo[q] : Ee[q];
#pragma unroll
                for (int j = 0; j < 4; ++j) { if (q < 4) p0[4 * q + j] *= e; else p1[4 * (q - 4) + j] *= e; } }
            pv<2>(o, lds + st * 65536 + 32768 + hh * 8192, vl, p0, p1);
        }
        if (i + 1 < nT) WRITE_T(st ^ 1);
        { const bool wd2 = (__builtin_amdgcn_ballot_w64(pc != 0.0f) == 0ull); if (lane == 0) ((LAS unsigned*)(lds + FL_OFF))[st * 8 + wid] = wd2 ? 1u : 0u; }
        __syncthreads();
        { const LAS unsigned* fl = (const LAS unsigned*)(lds + FL_OFF) + st * 8; const unsigned all = fl[0] & fl[1] & fl[2] & fl[3] & fl[4] & fl[5] & fl[6] & fl[7];
          if (__builtin_amdgcn_readfirstlane(all)) break; }
    }
    store_o<2>(A.obase + (rowbase + qrow) * PITCH + h * 64, o, hi);
#undef LOAD_T
#undef WRITE_T
}

__device__ __forceinline__ void unit_b(const AttnArgs& A, int b, int h, int qb, LAS unsigned char* lds) {
    int tid_ = threadIdx.x; asm volatile("" : "+v"(tid_));
    const int tid = tid_, lane = tid & 63, r32 = lane & 31, hi = lane >> 5; const int wid = __builtin_amdgcn_readfirstlane(tid >> 6);
    const int mp = wid >> 2, g4 = wid & 3;
    if (wid < 4) __builtin_amdgcn_s_setprio(2); else __builtin_amdgcn_s_setprio(0);
    const size_t rowbase = (size_t)b * SEQ; const int q0 = qb * 128;
    GAS bf16_t* qkv_ = A.qkv; const GAS float* ss_ = A.ss; asm volatile("" : "+s"(qkv_), "+s"(ss_));
    GAS bf16_t* Qb = qkv_ + 1 * BUF; const GAS bf16_t* Kb = qkv_ + 5 * BUF; const GAS bf16_t* Vb = qkv_ + 6 * BUF;
    const GAS float* ssq = ss_; const GAS float* ssk = ss_ + (size_t)2 * MROWS * 16;
    const int qrow = q0 + g4 * 32 + r32;
    const LAS float* prm = (const LAS float*)(lds + PRM_OFF); const float lam = prm[0], M0 = prm[1];
    bf16x8 qr[4];
    { const GAS bf16_t* qp = Qb + (rowbase + qrow) * PITCH + h * 128 + mp * 64; const GAS float* s = ssq + (rowbase + qrow) * 16 + 4 * h + 2 * mp;
      const float qs = C2 * __builtin_amdgcn_rsqf((s[0] + s[1]) * (1.0f / 64.0f) + 1e-6f);
#pragma unroll
      for (int d0 = 0; d0 < 4; ++d0) { const u32x4 raw = *(const GAS u32x4*)(qp + d0 * 16 + hi * 8); u32x4 w;
          const LAS float* g = prm + 32 + d0 * 16 + hi * 8; const f32x4 a0 = *(const LAS f32x4*)g * qs, a1 = *(const LAS f32x4*)(g + 4) * qs;
          w.x = cvt_pk_bf16(bf_lo(raw.x) * a0[0], bf_hi(raw.x) * a0[1]); w.y = cvt_pk_bf16(bf_lo(raw.y) * a0[2], bf_hi(raw.y) * a0[3]);
          w.z = cvt_pk_bf16(bf_lo(raw.z) * a1[0], bf_hi(raw.z) * a1[1]); w.w = cvt_pk_bf16(bf_lo(raw.w) * a1[2], bf_hi(raw.w) * a1[3]);
          qr[d0] = __builtin_bit_cast(bf16x8, w); } }
    const int nT = 2 * qb + 2; const int tw = 2 * qb + (g4 >> 1);
    const float slope2 = LOG2E * exp2f(-2.0f * (float)(h + 1));
    const GAS bf16_t* ksrc = Kb + (rowbase + lane) * PITCH + h * 128 + wid * 8;
    const GAS bf16_t* vsrc0 = Vb + (rowbase + 16 * (wid & 3) + (lane >> 2)) * PITCH + h * 128 + (wid >> 2) * 32 + (lane & 3) * 8;
    const GAS float* ksst = ssk + (rowbase + lane) * 16 + 4 * h;
    const int sdst = wid * 1024 + lane * 16;
    u32x4 k0r, k1r, v0r, v1r;
    f32x4 kss = {0.f, 0.f, 0.f, 0.f};
#define LOAD_T(t) do { const size_t o_ = (size_t)(t) * 64 * PITCH; k0r = *(const GAS u32x4*)(ksrc + o_); k1r = *(const GAS u32x4*)(ksrc + o_ + 64); v0r = *(const GAS u32x4*)(vsrc0 + o_); v1r = *(const GAS u32x4*)(vsrc0 + o_ + 64); \
        kss = *(const GAS f32x4*)(ksst + (size_t)(t) * 64 * 16); } while (0)
#define WRITE_T(st) do { LAS unsigned char* d_ = lds + (st) * 32768 + sdst; k0r = scale8(k0r, __builtin_amdgcn_rsqf((kss[0] + kss[1]) * (1.0f / 64.0f) + 1e-6f)); k1r = scale8(k1r, __builtin_amdgcn_rsqf((kss[2] + kss[3]) * (1.0f / 64.0f) + 1e-6f)); *(LAS u32x4*)(d_) = k0r; *(LAS u32x4*)(d_ + 8192) = k1r; *(LAS u32x4*)(d_ + 16384) = v0r; *(LAS u32x4*)(d_ + 16384 + 8192) = v1r; } while (0)
    const int vl = (4 * hi + ((lane & 15) >> 2)) * 64 + ((lane >> 4) & 1) * 32 + (lane & 3) * 8;
    f32x16 o[4]; o[0] = f32x16{}; o[1] = f32x16{}; o[2] = f32x16{}; o[3] = f32x16{};
    float l_run = 0.f;
    const int tfirst = [&] { const float dcut = 150.0f / slope2; const float x = ((float)(q0 - 63) - dcut) * (1.0f / 64.0f); int t0 = (x > 0.f) ? (int)x + 1 : 0; return t0 < nT - 1 ? t0 : nT - 1; }();
    LOAD_T(tfirst); WRITE_T(tfirst & 1); __syncthreads();
    for (int t = tfirst; t < nT; ++t) {
        const int st = t & 1;
        if (t + 1 < nT) LOAD_T(t + 1);
        if (t <= tw) {
            f32x16 p0, p1;
            const LAS unsigned char* kimg = lds + st * 32768 + mp * 8192; const LAS unsigned char* vimg = lds + st * 32768 + 16384;
            qkt_half(p0, kimg, qr, r32, hi, -M0, 0); qkt_half(p1, kimg, qr, r32, hi, -M0, 1);
            const float dq = (float)(qrow - 64 * t - 4 * hi);
            float sum0 = 0.f, sum1 = 0.f;
#pragma unroll
            for (int r = 0; r < 16; ++r) { const float kk = (float)((r & 3) + 8 * (r >> 2)); p0[r] = __builtin_amdgcn_exp2f(p0[r] - slope2 * fabsf(dq - kk)); sum0 += p0[r]; }
            pv_half<4>(o, vimg, vl, p0, 0);
#pragma unroll
            for (int r = 0; r < 16; ++r) { const float kk = (float)((r & 3) + 8 * (r >> 2)); p1[r] = __builtin_amdgcn_exp2f(p1[r] - slope2 * fabsf(dq - kk - 32.0f)); sum1 += p1[r]; }
            pv_half<4>(o, vimg, vl, p1, 1);
            l_run += sum0 + sum1;
        }
        if (t + 1 < nT) WRITE_T(st ^ 1);
        __syncthreads();
    }
    const float lt = l_run + __shfl_xor(l_run, 32), inv = __builtin_amdgcn_rcpf(lt);
    LAS float* X = (LAS float*)lds;
    const int xr = g4 * 32 + r32;
    if (mp == 1) { const float f = inv * lam;
#pragma unroll
        for (int bk = 0; bk < 4; ++bk)
#pragma unroll
            for (int r = 0; r < 16; ++r) X[(bk * 32 + (r & 3) + 8 * (r >> 2) + 4 * hi) * 128 + xr] = o[bk][r] * f; }
    __syncthreads();
    if (mp == 0) { float sq = 0.f;
#pragma unroll
        for (int bk = 0; bk < 4; ++bk)
#pragma unroll
            for (int r = 0; r < 16; ++r) { const float v = o[bk][r] * inv - X[(bk * 32 + (r & 3) + 8 * (r >> 2) + 4 * hi) * 128 + xr]; o[bk][r] = v; sq += v * v; }
        sq += __shfl_xor(sq, 32);
        const float rs = __builtin_amdgcn_rsqf(sq * (1.0f / 128.0f) + 1e-6f);
#pragma unroll
        for (int bk = 0; bk < 4; ++bk)
#pragma unroll
            for (int i = 0; i < 4; ++i) { const f32x4 gv = *(const LAS f32x4*)(prm + 160 + bk * 32 + 8 * i + 4 * hi);
#pragma unroll
                for (int j = 0; j < 4; ++j) o[bk][4 * i + j] *= rs * gv[j]; }
        store_o<4>(A.obase + 1 * BUF + (rowbase + qrow) * PITCH + h * 128, o, hi); }
    __syncthreads();
#undef LOAD_T
#undef WRITE_T
}

__device__ __forceinline__ void attn_phase(const AttnArgs& A, GAS unsigned* counters, LAS unsigned char* lds) {
    LAS unsigned* bc = (LAS unsigned*)(lds + BC_OFF);
    if (threadIdx.x < 64) {
        LAS float* prm = (LAS float*)(lds + PRM_OFF); const int ln = threadIdx.x;
        const GAS float* lq = A.lambda_qk; const float s1 = wave_sum(lq[ln] * lq[64 + ln]), s2 = wave_sum(lq[128 + ln] * lq[192 + ln]);
        const float gb = A.qk_g_diff[ln] * A.qk_g_diff[64 + ln], gc = A.qk_g_ch[ln] * A.qk_g_ch[64 + ln]; float gmb = fabsf(gb), gmc = fabsf(gc);
#pragma unroll
        for (int o_ = 1; o_ < 64; o_ <<= 1) { gmb = fmaxf(gmb, __shfl_xor(gmb, o_)); gmc = fmaxf(gmc, __shfl_xor(gmc, o_)); }
        prm[32 + ln] = gb; prm[96 + ln] = gc; prm[160 + ln] = A.subln_g[ln] * (1.0f - A.lam_init); prm[224 + ln] = A.subln_g[64 + ln] * (1.0f - A.lam_init);
        const float M0c = 8.0f * gmc * LOG2E * 1.02f;
        if (ln == 0) { prm[0] = __expf(s1) - __expf(s2) + A.lam_init; prm[1] = 8.0f * gmb * LOG2E * 1.02f; }
        for (int hc = 0; hc < 8; ++hc) { float bmx = -3.0e38f, bmn = 3.0e38f;
            for (int j = ln; j < 257; j += 64) { const float v = A.rel_bias[hc * 257 + j]; bmx = fmaxf(bmx, v); bmn = fminf(bmn, v); }
#pragma unroll
            for (int o_ = 1; o_ < 64; o_ <<= 1) { bmx = fmaxf(bmx, __shfl_xor(bmx, o_)); bmn = fminf(bmn, __shfl_xor(bmn, o_)); }
            if (ln == 0) { prm[2 + hc] = M0c + bmx * LOG2E; prm[10 + hc] = (2.0f * M0c + (bmx - bmn) * LOG2E < 100.0f) ? 1.0f : 0.0f; } }
    }
    __syncthreads();
    const int x0 = (int)(__builtin_amdgcn_s_getreg((3 << 11) | 20) & 7u);
#pragma unroll 1
    for (int qn = 0; qn < 8; ++qn) {
        const int x = (x0 + qn) & 7; GAS unsigned* counter = counters + 64 * x;
        for (;;) {
            if (threadIdx.x == 0) *bc = __hip_atomic_fetch_add(counter, 1u, __ATOMIC_RELAXED, __HIP_MEMORY_SCOPE_AGENT);
            __syncthreads();
            const int idx = (int)__builtin_amdgcn_readfirstlane(*bc);
            __syncthreads();
            if (idx >= 384) break;
            if (idx < 128) { const int bh = x + 8 * (idx >> 4); unit_b(A, bh >> 2, bh & 3, 15 - (idx & 15), lds); }
            else if (idx < 256) { const int jc = idx - 128; const int bh = x + 8 * (jc >> 3); const int hc = bh & 7;
                const float shift = ((const LAS float*)(lds + PRM_OFF))[2 + hc]; const bool fixc = __builtin_amdgcn_readfirstlane(__float_as_uint(((const LAS float*)(lds + PRM_OFF))[10 + hc])) != 0u;
                if (fixc) unit_ac<2, true>(A, bh >> 3, hc, 7 - (jc & 7), lds, shift);
                else unit_ac<2, false>(A, bh >> 3, hc, 7 - (jc & 7), lds, 0.f); }
            else { const int ja = idx - 256; const int pr = x + 8 * (ja >> 5); unit_a4(A, pr >> 1, pr & 1, 31 - (ja & 31), lds); }
        }
    }
    __builtin_amdgcn_s_setprio(0);
}
#undef LAS
#undef MFMA32
}
#define LAS __attribute__((address_space(3)))
typedef unsigned short bf16_t;
typedef unsigned v4u __attribute__((ext_vector_type(4)));
typedef float f32x4 __attribute__((ext_vector_type(4)));
constexpr int NWAVES = 8;
constexpr int MT = 32768, DM = 1024, NQKV = 4608, NGATE = 3072, NIN = 7680, DFF = 2816, DEPTH = 4;
constexpr size_t MiB = 1u << 20;
constexpr size_t WS_CTL = 0, CTL_BYTES = 65536;
constexpr size_t WS_ROWSS = 1 * MiB, WS_SS = 3 * MiB, WS_RS1 = 11 * MiB;
constexpr size_t WS_WIN = 12 * MiB, WS_WB = 27 * MiB, WS_WOUT = 30 * MiB, WS_WGU = 32 * MiB, WS_WDOWN = 43 * MiB;
constexpr size_t WS_XB = 50 * MiB, WS_QKV = 114 * MiB, WS_G2 = 402 * MiB, WS_MERGED = WS_QKV + 3 * 32 * MiB  , WS_ACT = WS_QKV, WS_END = 466 * MiB;
constexpr int LDS_BYTES = 147456;

__device__ __forceinline__ unsigned f2bf(float f) { unsigned u = __builtin_bit_cast(unsigned, f); return (u + 0x7fffu + ((u >> 16) & 1u)) >> 16; }
__device__ __forceinline__ unsigned pk2(float lo, float hi) { return f2bf(lo) | (f2bf(hi) << 16); }
#define LDS_WAIT() asm volatile("s_waitcnt lgkmcnt(0)" ::: "memory")

template <class RowMap> __device__ __forceinline__ void transpose_item(const GAS float* W, int K, int N, GAS bf16_t* WT, const GAS float* gain, LAS float* scr, int item, int lane, RowMap rm) {
    const int nblk = N / 32, kb = item / nblk, nb = item % nblk, k0 = 64 * kb, n0 = 32 * nb;
    const int kr = lane >> 3, nc = 4 * (lane & 7);
    f32x4 v[8]; float gv[8];
#pragma unroll
    for (int i = 0; i < 8; ++i) { v[i] = *(const GAS f32x4*)(W + (size_t)(k0 + kr + 8 * i) * N + n0 + nc); gv[i] = gain ? gain[k0 + kr + 8 * i] : 1.0f; }
#pragma unroll
    for (int i = 0; i < 8; ++i) { LAS float* d = scr + (kr + 8 * i) * 33 + nc; const f32x4 w = v[i] * gv[i]; d[0] = w[0]; d[1] = w[1]; d[2] = w[2]; d[3] = w[3]; }
    LDS_WAIT(); asm volatile("" ::: "memory");
    const int c = lane & 7;
#pragma unroll
    for (int j = 0; j < 4; ++j) { const int n = (lane >> 3) + 8 * j; const LAS float* s = scr + (8 * c) * 33 + n;
        v4u o; o.x = pk2(s[0 * 33], s[1 * 33]); o.y = pk2(s[2 * 33], s[3 * 33]); o.z = pk2(s[4 * 33], s[5 * 33]); o.w = pk2(s[6 * 33], s[7 * 33]);
        *(GAS v4u*)(WT + (size_t)rm(n0 + n) * K + k0 + 8 * c) = o; }
    LDS_WAIT(); asm volatile("" ::: "memory");
}
struct MapId { int off; __device__ int operator()(int n) const { return off + n; } };
struct MapIn { __device__ int operator()(int n) const { if (n >= 4608) return n; const int s = n >> 9; const int d = (int)((0x872651430ULL >> (4 * s)) & 15ULL); return d * 512 + (n & 511); } };
struct MapGU { __device__ int operator()(int n) const { const int up = n >= 2816 ? 1 : 0; const int c = n - up * 2816; return (c >> 2) * 8 + up * 4 + (c & 3); } };

__device__ __forceinline__ unsigned long long ldptr(volatile LAS unsigned long long* PT, int i) { asm volatile("" : "+v"(PT)); const unsigned long long v = PT[i]; const unsigned lo = __builtin_amdgcn_readfirstlane((unsigned)v), hi = __builtin_amdgcn_readfirstlane((unsigned)(v >> 32)); return ((unsigned long long)hi << 32) | lo; }
#define XB_TMO      128
#define XB_XCNT(j)  (256  + 64 * (j))
#define XB_XSUB(j)  (1280 + 64 * (j))
#define XB_XGEN(j)  (2304 + 64 * (j))
#define XB_TOP      3328
#define XB_TOPGEN   3392
#define XCD_BAR_WORDS 3456
#define XB_SPIN_CAP (1u << 18)

__device__ __forceinline__ unsigned xb_ld(GAS unsigned* p)              { return __hip_atomic_load(p, __ATOMIC_RELAXED, __HIP_MEMORY_SCOPE_AGENT); }
__device__ __forceinline__ unsigned xb_add(GAS unsigned* p, unsigned v) { return __hip_atomic_fetch_add(p, v, __ATOMIC_RELAXED, __HIP_MEMORY_SCOPE_AGENT); }
__device__ __forceinline__ unsigned xb_xcc_id() { return (unsigned)__builtin_amdgcn_s_getreg((3 << 11) | 20) & 0xFu; }
#define XB_SPIN(cond, bar) do { unsigned _sp = 0; while (cond) { __builtin_amdgcn_s_sleep(1); \
    if ((++_sp & 255u) == 0u) { if (xb_ld(&(bar)[XB_TMO])) break; if (_sp > XB_SPIN_CAP) { xb_add(&(bar)[XB_TMO], 1u); break; } } } } while (0)

struct XcdBarrier {
    GAS unsigned* bar; unsigned x;
    volatile LAS unsigned* st;
};

__device__ __forceinline__ XcdBarrier xcd_barrier_post(GAS unsigned* bar, volatile LAS unsigned* st) {
    XcdBarrier b; b.bar = bar; b.x = xb_xcc_id(); b.st = st;
    if (threadIdx.x == 0) (void)xb_add(&bar[XB_XCNT(b.x)], 1u);
    return b;
}
__device__ __forceinline__ void xcd_barrier_complete(GAS unsigned* bar, unsigned x, unsigned& nloc, unsigned& nx) {
    const unsigned G = gridDim.x * gridDim.y * gridDim.z;
    unsigned sum, cnt, mine, sp = 0u;
    for (;;) {
        sum = 0u; cnt = 0u; mine = 0u;
#pragma unroll
        for (unsigned j = 0; j < 16; ++j) { const unsigned c = xb_ld(&bar[XB_XCNT(j)]); sum += c; cnt += (c > 0u) ? 1u : 0u; mine = (j == x) ? c : mine; }
        if (sum == G) break;
        __builtin_amdgcn_s_sleep(1);
        if ((++sp & 255u) == 0u) { if (xb_ld(&bar[XB_TMO])) break; if (sp > XB_SPIN_CAP) { xb_add(&bar[XB_TMO], 1u); break; } }
    }
    nloc = mine > 0u ? mine : 1u; nx = cnt > 0u ? cnt : 1u;
}

__device__ __forceinline__ void xcd_barrier(const XcdBarrier& b) {
    asm volatile("s_waitcnt vmcnt(0)" ::: "memory");
    __syncthreads();
    if (threadIdx.x == 0) {
        GAS unsigned* bar = b.bar;
        __builtin_amdgcn_s_waitcnt(0);
        unsigned nloc = b.st[0], nx = b.st[1];
        if (nloc == 0u) { xcd_barrier_complete(bar, b.x, nloc, nx); b.st[0] = nloc; b.st[1] = nx; }
        const unsigned old = xb_add(&bar[XB_XSUB(b.x)], 1u);
        const unsigned gen = old / nloc;
        if (old + 1u == (gen + 1u) * nloc) {
            __builtin_amdgcn_fence(__ATOMIC_RELEASE, "agent");
            asm volatile("s_waitcnt vmcnt(0)" ::: "memory");
            const unsigned og = xb_add(&bar[XB_TOP], 1u);
            const unsigned tg = og / nx;
            if (og + 1u == (tg + 1u) * nx) xb_add(&bar[XB_TOPGEN], 1u);
            else XB_SPIN(xb_ld(&bar[XB_TOPGEN]) == tg, bar);
            __builtin_amdgcn_fence(__ATOMIC_ACQUIRE, "agent");
            xb_add(&bar[XB_XGEN(b.x)], 1u);
            asm volatile("s_waitcnt vmcnt(0)" ::: "memory");
        } else {
            XB_SPIN(xb_ld(&bar[XB_XGEN(b.x)]) == gen, bar);
            __builtin_amdgcn_fence(__ATOMIC_ACQUIRE, "agent");
            asm volatile("s_waitcnt vmcnt(0)" ::: "memory");
        }
    }
    __syncthreads();
}
struct Args { const GAS float* in[16]; GAS float* out; unsigned char* ws; int ph_lo, ph_hi; };

__global__ void __launch_bounds__(NWAVES * 64, 2) fwd_kernel(Args args) {
    extern __shared__ __attribute__((aligned(16))) unsigned char lds_raw[];
    LAS unsigned char* lds = (LAS unsigned char*)lds_raw;
    cg::grid_group grid = cg::this_grid();
    const int tid = threadIdx.x;
    volatile LAS unsigned long long* PT = (volatile LAS unsigned long long*)(lds + 131072 + 2048);
    { unsigned long long v = (unsigned long long)args.ws;
#pragma unroll
      for (int i = 0; i < 16; ++i) v = (tid == i) ? (unsigned long long)args.in[i] : v;
      v = (tid == 16) ? (unsigned long long)args.out : v;
      if (tid < 18) PT[tid] = v; }
    volatile LAS unsigned* MISC = (volatile LAS unsigned*)(lds + 131072 + 1024);
    if (tid < 2) MISC[tid] = 0u;
    (void)xcd_barrier_post((GAS unsigned*)args.ws + 1024, MISC);
    __syncthreads();
#define PTRF(i) ((const GAS float*)ldptr(PT, (i)))
#define WSP(off) ((GAS unsigned char*)ldptr(PT, 17) + (off))
#define OUTP ((GAS float*)ldptr(PT, 16))
    const int lo = args.ph_lo, hi_ph = args.ph_hi;
#ifndef PHMASK
#define PHMASK 255
#endif
#define REP_G1 1
#define REP_GG 1
#define REP_G2 1
#define REP_G4 1
#define REP_G3 1
#define REP_G5 1
#ifndef REP_ATT
#define REP_ATT 1
#endif
#ifndef REP_P0
#define REP_P0 1
#endif
#ifndef EXTRA_SYNC
#define EXTRA_SYNC 0
#endif
#define IN(k) (((PHMASK >> ((k) & 7)) & 1) && lo <= (k) && (k) < hi_ph)
#define SEAM(k) do { if (IN(k) && IN((k) + 1)) { if ((k) == 0) grid.sync(); else { XcdBarrier xb_; xb_.bar = (GAS unsigned*)WSP(WS_CTL) + 1024; xb_.x = xb_xcc_id(); xb_.st = MISC; xcd_barrier(xb_); } } } while (0)
#pragma unroll 1
    for (int l = 0; l < DEPTH; ++l) {
        const int P = l * 8;
        if (IN(P + 0))
_Pragma("unroll 1")
        for (int rep_ = 0; rep_ < REP_P0; ++rep_) {
            int bid = blockIdx.x, Gl = gridDim.x; asm volatile("" : "+s"(bid), "+s"(Gl));
            int tl = threadIdx.x; asm volatile("" : "+v"(tl)); const int lane = tl & 63, wave = __builtin_amdgcn_readfirstlane(tl >> 6);
            LAS float* scr = (LAS float*)(lds + wave * 16384); const int gw = bid * NWAVES + wave, NGW = Gl * NWAVES;
            const GAS float* w_in = PTRF(2) + (size_t)l * DM * NIN; const GAS float* g_mix = PTRF(1) + (size_t)l * DM;
            const GAS float* w_sb = PTRF(9) + (size_t)l * 512 * DM; const GAS float* w_df = PTRF(10) + (size_t)l * 512 * DM; const GAS float* w_ch = PTRF(11) + (size_t)l * 512 * DM;
            const GAS float* w_out = PTRF(12) + (size_t)l * DM * DM; const GAS float* g_ffn = PTRF(13) + (size_t)l * DM;
            const GAS float* w_gu = PTRF(14) + (size_t)l * DM * 2 * DFF; const GAS float* w_down = PTRF(15) + (size_t)l * DFF * DM;
            constexpr int I_IN = (DM / 64) * (NIN / 32), I_B = (512 / 64) * (DM / 32), I_O = (DM / 64) * (DM / 32), I_GU = (DM / 64) * (2 * DFF / 32), I_DN = (DFF / 64) * (DM / 32);
            constexpr int NITEMS = I_IN + 3 * I_B + I_O + I_GU + I_DN;
            for (int it = gw; it < NITEMS; it += NGW) {
                int r = it;
                if (r < I_IN) { transpose_item(w_in, DM, NIN, ((GAS bf16_t*)WSP(WS_WIN)), g_mix, scr, r, lane, MapIn{}); continue; } r -= I_IN;
                if (r < I_B) { transpose_item(w_sb, 512, DM, ((GAS bf16_t*)WSP(WS_WB)), nullptr, scr, r, lane, MapId{0}); continue; } r -= I_B;
                if (r < I_B) { transpose_item(w_df, 512, DM, ((GAS bf16_t*)WSP(WS_WB)), nullptr, scr, r, lane, MapId{1024}); continue; } r -= I_B;
                if (r < I_B) { transpose_item(w_ch, 512, DM, ((GAS bf16_t*)WSP(WS_WB)), nullptr, scr, r, lane, MapId{2048}); continue; } r -= I_B;
                if (r < I_O) { transpose_item(w_out, DM, DM, ((GAS bf16_t*)WSP(WS_WOUT)), nullptr, scr, r, lane, MapId{0}); continue; } r -= I_O;
                if (r < I_GU) { transpose_item(w_gu, DM, 2 * DFF, ((GAS bf16_t*)WSP(WS_WGU)), g_ffn, scr, r, lane, MapGU{}); continue; } r -= I_GU;
                transpose_item(w_down, DFF, DM, ((GAS bf16_t*)WSP(WS_WDOWN)), nullptr, scr, r, lane, MapId{0});
            }
            if (l == 0) {
                for (int m = gw; m < MT; m += NGW) { const GAS f32x4* xr = (const GAS f32x4*)(PTRF(0) + (size_t)m * DM) + lane; f32x4 v[4]; float s = 0.f;
#pragma unroll
                    for (int j = 0; j < 4; ++j) { v[j] = xr[64 * j]; s += (v[j][0] * v[j][0] + v[j][1] * v[j][1]) + (v[j][2] * v[j][2] + v[j][3] * v[j][3]); }
                    s = att::wave_sum(s);
                    GAS unsigned long long* o8 = (GAS unsigned long long*)(((GAS bf16_t*)WSP(WS_XB)) + (size_t)m * DM) + lane;
#pragma unroll
                    for (int j = 0; j < 4; ++j) o8[64 * j] = (unsigned long long)pk2(v[j][0], v[j][1]) | ((unsigned long long)pk2(v[j][2], v[j][3]) << 32);
                    if (lane < 16) ((GAS float*)WSP(WS_ROWSS))[(size_t)m * 16 + lane] = (lane == 0) ? s : 0.f;
                    if (lane == 0) ((GAS float*)WSP(WS_RS1))[m] = __builtin_amdgcn_rsqf(s * (1.0f / 1024.0f) + 1e-6f); }
            } else {
                for (int m = gw * 64 + lane; m < MT; m += NGW * 64) ((GAS float*)WSP(WS_RS1))[m] = pg8::row_rs((const GAS float*)WSP(WS_ROWSS), m);
            }
        }
        SEAM(P + 0);
        for (int xs_ = 0; xs_ < EXTRA_SYNC; ++xs_) grid.sync();
        if (IN(P + 1))
_Pragma("unroll 1")
        for (int rep_ = 0; rep_ < REP_G1; ++rep_) {
            int bid = blockIdx.x, Gl = gridDim.x; asm volatile("" : "+s"(bid), "+s"(Gl));
            pg8::Gemm g{((GAS bf16_t*)WSP(WS_XB)), ((GAS bf16_t*)WSP(WS_WIN)), MT, NIN, DM}; pg8::StaticOrder S; S.init(MT, NIN, Gl, bid);
            pg8::EpiQKVG E{pg8::EpiQKV{((GAS bf16_t*)WSP(WS_QKV)), ((GAS float*)WSP(WS_ROWSS)), ((GAS float*)WSP(WS_SS)), ((const GAS float*)WSP(WS_RS1))}, (GAS bf16_t*)OUTP, (GAS bf16_t*)WSP(WS_G2), PTRF(3) + (size_t)l * NGATE};
            pg8::gemm_phase<pg8::EpiQKVG, pg8::StaticOrder, true, true>(lds, g, S, E);
        }
        SEAM(P + 1);
        if (IN(P + 2))
_Pragma("unroll 1")
        for (int rep_ = 0; rep_ < REP_ATT; ++rep_) {
            int bid = blockIdx.x, Gl = gridDim.x; asm volatile("" : "+s"(bid), "+s"(Gl));
            att::AttnArgs A{((GAS bf16_t*)WSP(WS_QKV)), ((GAS bf16_t*)WSP(rep_ + 1 < REP_ATT ? WS_MERGED : WS_QKV)), ((GAS float*)WSP(WS_SS)), PTRF(4) + (size_t)l * 128, PTRF(5) + (size_t)l * 256, PTRF(6) + (size_t)l * 128, PTRF(7) + (size_t)l * 128, PTRF(8) + (size_t)l * 8 * 257, 0.8f - 0.6f * __expf(-0.3f * (float)l)};
            att::attn_phase(A, ((GAS unsigned*)WSP(WS_CTL)) + 8192 + 512 * (l + 4 * rep_), lds);
            if (rep_ + 1 < REP_ATT) grid.sync();
        }
        SEAM(P + 2);
        if (IN(P + 4))
_Pragma("unroll 1")
        for (int rep_ = 0; rep_ < REP_G2; ++rep_) {
            int bid = blockIdx.x, Gl = gridDim.x; asm volatile("" : "+s"(bid), "+s"(Gl));
            pg8::Gemm g{((GAS bf16_t*)WSP(WS_QKV)), ((GAS bf16_t*)WSP(WS_WB)), 3 * MT, 3 * DM, 512}; const int vcu = (Gl % 8 == 0) ? (bid % 8) * (Gl / 8) + bid / 8 : bid; pg8::BranchOrder S{Gl, vcu};
            pg8::EpiBranch E{(const GAS bf16_t*)OUTP, (const GAS bf16_t*)WSP(WS_G2), ((GAS bf16_t*)WSP(WS_MERGED))};
            pg8::gemm_phase<pg8::EpiBranch, pg8::BranchOrder, true, true>(lds, g, S, E);
        }
        SEAM(P + 4);
        if (IN(P + 5))
_Pragma("unroll 1")
        for (int rep_ = 0; rep_ < REP_G3; ++rep_) {
            int bid = blockIdx.x, Gl = gridDim.x; asm volatile("" : "+s"(bid), "+s"(Gl));
            pg8::Gemm g{((GAS bf16_t*)WSP(WS_MERGED)), ((GAS bf16_t*)WSP(WS_WOUT)), MT, DM, DM}; pg8::StaticOrder S; S.init(MT, DM, Gl, bid);
            pg8::EpiResid E{(GAS float*)nullptr, ((GAS bf16_t*)WSP(WS_XB)), ((GAS float*)WSP(WS_ROWSS))};
            pg8::gemm_phase<pg8::EpiResid, pg8::StaticOrder, true, true>(lds, g, S, E);
        }
        SEAM(P + 5);
        if (IN(P + 6))
_Pragma("unroll 1")
        for (int rep_ = 0; rep_ < REP_G4; ++rep_) {
            int bid = blockIdx.x, Gl = gridDim.x; asm volatile("" : "+s"(bid), "+s"(Gl));
            pg8::Gemm g{((GAS bf16_t*)WSP(WS_XB)), ((GAS bf16_t*)WSP(WS_WGU)), MT, 2 * DFF, DM}; pg8::StaticOrder S; S.init(MT, 2 * DFF, Gl, bid);
            pg8::EpiSwiGLU E{((GAS bf16_t*)WSP(WS_ACT)), ((GAS float*)WSP(WS_ROWSS))};
            pg8::gemm_phase<pg8::EpiSwiGLU, pg8::StaticOrder, true, true>(lds, g, S, E);
        }
        SEAM(P + 6);
        if (IN(P + 7))
_Pragma("unroll 1")
        for (int rep_ = 0; rep_ < REP_G5; ++rep_) {
            int bid = blockIdx.x, Gl = gridDim.x; asm volatile("" : "+s"(bid), "+s"(Gl));
            pg8::Gemm g{((GAS bf16_t*)WSP(WS_ACT)), ((GAS bf16_t*)WSP(WS_WDOWN)), MT, DM, DFF}; pg8::StaticOrder S; S.init(MT, DM, Gl, bid);
            pg8::EpiResid E{(l == DEPTH - 1) ? OUTP : (GAS float*)nullptr, ((GAS bf16_t*)WSP(WS_XB)), ((GAS float*)WSP(WS_ROWSS))};
            pg8::gemm_phase<pg8::EpiResid, pg8::StaticOrder, true, true>(lds, g, S, E);
        }
        SEAM(P + 7);
    }
#undef IN
#undef SEAM
}

#ifndef MK_SPLIT
#define MK_SPLIT 0
#endif
extern "C" void kernel_launch(void* const* d_in, const int* in_sizes, int n_in, void* d_out, int out_size, void* d_ws, size_t ws_size, hipStream_t stream) {
    static int grid = 0;
    if (grid == 0) {
        if (n_in != 16 || in_sizes[0] != MT * DM || out_size != MT * DM || ws_size < WS_END) { fprintf(stderr, "kernel_launch: unexpected shapes / workspace (n_in %d, ws %zu); nothing launched\n", n_in, ws_size); grid = -1; return; }
        int dev = 0, cus = 0, per_cu = 0;
        if (hipGetDevice(&dev) != hipSuccess || hipDeviceGetAttribute(&cus, hipDeviceAttributeMultiprocessorCount, dev) != hipSuccess) { grid = -1; return; }
        if (hipFuncSetAttribute((const void*)fwd_kernel, hipFuncAttributeMaxDynamicSharedMemorySize, LDS_BYTES) != hipSuccess) { fprintf(stderr, "kernel_launch: hipFuncSetAttribute failed\n"); grid = -1; return; }
        if (hipOccupancyMaxActiveBlocksPerMultiprocessor(&per_cu, (const void*)fwd_kernel, NWAVES * 64, LDS_BYTES) != hipSuccess || per_cu < 1) { fprintf(stderr, "kernel_launch: occupancy query says %d blocks per CU\n", per_cu); per_cu = 1; }
        (void)hipGetLastError();
        grid = cus;
    }
    if (grid < 0) return;
    (void)hipMemsetAsync((char*)d_ws + WS_CTL, 0, CTL_BYTES, stream);
    Args a{};
    for (int i = 0; i < 16; ++i) a.in[i] = (const GAS float*)d_in[i];
    a.out = (GAS float*)d_out; a.ws = (unsigned char*)d_ws;
#if MK_SPLIT
    for (int p = 0; p < 8 * DEPTH; ++p) { a.ph_lo = p; a.ph_hi = p + 1; hipLaunchKernelGGL(fwd_kernel, dim3(grid), dim3(NWAVES * 64), LDS_BYTES, stream, a); }
#else
    a.ph_lo = 0; a.ph_hi = 8 * DEPTH;
    void* kargs[] = {&a};
    hipError_t e = hipLaunchCooperativeKernel((const void*)fwd_kernel, dim3(grid), dim3(NWAVES * 64), kargs, LDS_BYTES, stream);
    if (e != hipSuccess) fprintf(stderr, "kernel_launch: cooperative launch failed: %s (grid %d)\n", hipGetErrorString(e), grid);
#endif
}
```

```cpp
#include <hip/hip_runtime.h>
#include <hip/hip_cooperative_groups.h>
#include <cstdio>
#include <cstdint>
namespace cg = cooperative_groups;
#define GAS __attribute__((address_space(1)))
namespace pg8 {
#define PG8_LAS __attribute__((address_space(3)))
typedef unsigned short bf16_t;
typedef short bf16x8 __attribute__((ext_vector_type(8)));
typedef float f32x4 __attribute__((ext_vector_type(4)));
typedef unsigned u32x4 __attribute__((ext_vector_type(4)));
constexpr int BM = 256, BK = 64, HALF = 128, HTB = HALF * BK * 2  , STAGE_BYTES = 8 * HTB, NXCD = 8, WGM = 4;

__host__ __device__ __forceinline__ int lds_byte(int r, int c) { const int st = (r >> 4) * 2 + (c >> 5), rr = r & 15, cc = c & 31, ob = rr * 64 + cc * 2; return st * 1024 + (ob ^ (((ob >> 9) & 1) << 5)); }
__host__ __device__ __forceinline__ void stage_rc(int b, int& R, int& C) { const int st = b / 1024, sb = b % 1024, swz = sb ^ (((sb >> 9) & 1) << 5); R = (st >> 1) * 16 + swz / 64; C = (st & 1) * 32 + (swz % 64) / 2; }
__host__ __device__ __forceinline__ int perm32(int rho) { const int n = rho >> 4, i = rho & 15; return 8 * (i >> 2) + 4 * n + (i & 3); }

struct Unit { int pm, pn; };
struct Gemm { const __attribute__((address_space(1))) bf16_t* A; const __attribute__((address_space(1))) bf16_t* Bt; int M, N, K; };

struct StaticOrder {
    int nM, nN, nwg, G, c;
    __host__ __device__ void init(int M, int N, int G_, int c_) { nM = M / BM; nN = N / BM; nwg = nM * nN; G = G_; c = c_; }
    __host__ __device__ bool next(int i, Unit& u) const {
        const long L = (long)i * G + c; if (L >= nwg) return false;
        int wgid = (int)L; { const int q = nwg / NXCD, r = nwg % NXCD, xcd = wgid % NXCD, off = wgid / NXCD; wgid = (xcd < r ? xcd * (q + 1) : r * (q + 1) + (xcd - r) * q) + off; }
        const int nig = WGM * nN, gid = wgid / nig, fm = gid * WGM, gsz = (nM - fm) < WGM ? (nM - fm) : WGM;
        u.pm = fm + ((wgid % nig) % gsz); u.pn = (wgid % nig) / gsz; return true;
    }
    __device__ __forceinline__ void a_ready(const Unit&) const {}
    __device__ __forceinline__ void done(const Unit&) const {}
};

typedef float f32x2 __attribute__((ext_vector_type(2)));
typedef __bf16 bf16x2_t __attribute__((ext_vector_type(2)));
typedef unsigned u32x2 __attribute__((ext_vector_type(2)));
__device__ __forceinline__ unsigned cvt_pk_bf16(float lo, float hi) { f32x2 v = {lo, hi}; bf16x2_t b = __builtin_convertvector(v, bf16x2_t); return __builtin_bit_cast(unsigned, b); }
__device__ __forceinline__ float bf_lo(unsigned u) { return __uint_as_float(u << 16); }
__device__ __forceinline__ float bf_hi(unsigned u) { return __uint_as_float(u & 0xffff0000u); }
constexpr int MROWS = 32768;
constexpr float LOG2E = 1.4426950408889634f;
__device__ __forceinline__ float sigmoid_f(float x) { return __builtin_amdgcn_rcpf(1.0f + __builtin_amdgcn_exp2f(-x * LOG2E)); }
__device__ __forceinline__ float row_rs(const GAS float* rowss, int row) {
    const GAS f32x4* p = (const GAS f32x4*)(rowss + (size_t)row * 16); const f32x4 a = p[0], b = p[1], c = p[2], d = p[3];
    const float s = ((a[0] + a[1]) + (a[2] + a[3])) + ((b[0] + b[1]) + (b[2] + b[3])) + ((c[0] + c[1]) + (c[2] + c[3])) + ((d[0] + d[1]) + (d[2] + d[3]));
    return __builtin_amdgcn_rsqf(s * (1.0f / 1024.0f) + 1e-6f);
}
struct EpiQKV {
    static constexpr bool PERM = true, AFTER_DRAIN = false, CHAIN = false;
    GAS bf16_t* QKV; const GAS float* rowss; GAS float* ss; const GAS float* rs1;
    __device__ __forceinline__ void operator()(const f32x4 (&acc)[2][2][4][2], const Unit& u, int wr, int wc, int fr, int fq) const {
        const int row0 = u.pm * BM + wr * 64 + fr; const int t = u.pn >> 1, colt = (u.pn & 1) * 256;
        GAS bf16_t* base = QKV + (size_t)t * MROWS * 512; const int col0 = colt + wc * 32 + 8 * fq;
        const int sidx = (t == 1) ? 0 : (t == 2) ? 1 : (t == 5) ? 2 : (t == 7) ? 3 : -1;
#pragma unroll
        for (int ai = 0; ai < 2; ++ai)
#pragma unroll
            for (int m = 0; m < 4; ++m) { const int row = row0 + ai * HALF + m * 16; const float rs = rs1[row]; GAS bf16_t* rowp = base + (size_t)row * 512 + col0;
#pragma unroll
                for (int bj = 0; bj < 2; ++bj) { const f32x4 v0 = acc[ai][bj][m][0] * rs, v1 = acc[ai][bj][m][1] * rs;
                    u32x4 w; w.x = cvt_pk_bf16(v0[0], v0[1]); w.y = cvt_pk_bf16(v0[2], v0[3]); w.z = cvt_pk_bf16(v1[0], v1[1]); w.w = cvt_pk_bf16(v1[2], v1[3]);
                    *(GAS u32x4*)(rowp + bj * HALF) = w;
                    if (sidx >= 0) { float q = ((v0[0] * v0[0] + v0[1] * v0[1]) + (v0[2] * v0[2] + v0[3] * v0[3])) + ((v1[0] * v1[0] + v1[1] * v1[1]) + (v1[2] * v1[2] + v1[3] * v1[3]));
                        q += __shfl_xor(q, 16); q += __shfl_xor(q, 32);
                        if (fq == 0) ss[((size_t)sidx * MROWS + row) * 16 + (colt >> 5) + 4 * bj + wc] = q; } } }
    }
};
struct EpiQKVG {
    static constexpr bool PERM = true, AFTER_DRAIN = false, CHAIN = false;
    EpiQKV q; GAS bf16_t* g01; GAS bf16_t* g2; const GAS float* bias;
    __device__ __forceinline__ void operator()(const f32x4 (&acc)[2][2][4][2], const Unit& u, int wr, int wc, int fr, int fq) const {
        if (u.pn < 18) { q(acc, u, wr, wc, fr, fq); return; }
        const int c = u.pn - 18, br = c >> 2; GAS bf16_t* G = (br < 2) ? g01 + (size_t)br * MROWS * 1024 : g2;
        const int row0 = u.pm * BM + wr * 64 + fr; const int col0 = (c & 3) * BM + wc * 32 + 8 * fq;
        f32x4 bv[2][2];
#pragma unroll
        for (int bj = 0; bj < 2; ++bj)
#pragma unroll
            for (int n = 0; n < 2; ++n) bv[bj][n] = *(const GAS f32x4*)(bias + br * 1024 + col0 + bj * HALF + 4 * n);
#pragma unroll
        for (int ai = 0; ai < 2; ++ai)
#pragma unroll
            for (int m = 0; m < 4; ++m) { const int row = row0 + ai * HALF + m * 16; const float rs = q.rs1[row]; GAS bf16_t* rowp = G + (size_t)row * 1024 + col0;
#pragma unroll
                for (int bj = 0; bj < 2; ++bj) { const f32x4 v0 = acc[ai][bj][m][0] * rs + bv[bj][0], v1 = acc[ai][bj][m][1] * rs + bv[bj][1];
                    u32x4 w; w.x = cvt_pk_bf16(fmaxf(sigmoid_f(v0[0]), 1e-30f), fmaxf(sigmoid_f(v0[1]), 1e-30f)); w.y = cvt_pk_bf16(fmaxf(sigmoid_f(v0[2]), 1e-30f), fmaxf(sigmoid_f(v0[3]), 1e-30f));
                    w.z = cvt_pk_bf16(fmaxf(sigmoid_f(v1[0]), 1e-30f), fmaxf(sigmoid_f(v1[1]), 1e-30f)); w.w = cvt_pk_bf16(fmaxf(sigmoid_f(v1[2]), 1e-30f), fmaxf(sigmoid_f(v1[3]), 1e-30f));
                    *(GAS u32x4*)(rowp + bj * HALF) = w; } }
    }
};
struct EpiBranch {
    static constexpr bool PERM = true, AFTER_DRAIN = false, CHAIN = true;
    const GAS bf16_t* g01; const GAS bf16_t* g2; GAS bf16_t* Mg;
    __device__ __forceinline__ bool keep(const Unit& u) const { return (u.pm >> 7) < 2; }
    __device__ __forceinline__ void operator()(f32x4 (&acc)[2][2][4][2], const Unit& u, int wr, int wc, int fr, int fq) const {
        const int br = u.pm >> 7, pm = u.pm & 127, pn = u.pn & 3;
        const int row0 = pm * BM + wr * 64 + fr; const int col0 = pn * BM + wc * 32 + 8 * fq;
#pragma unroll
        for (int ai = 0; ai < 2; ++ai)
#pragma unroll
            for (int m = 0; m < 4; ++m) { const int row = row0 + ai * HALF + m * 16; const GAS bf16_t* gp = ((br < 2) ? g01 + (size_t)br * MROWS * 1024 : g2) + (size_t)row * 1024 + col0; const GAS bf16_t* gn = ((br == 0) ? g01 + (size_t)MROWS * 1024 : g2) + (size_t)row * 1024 + col0; GAS bf16_t* mp = Mg + (size_t)row * 1024 + col0;
#pragma unroll
                for (int bj = 0; bj < 2; ++bj) { const u32x4 g = *(const GAS u32x4*)(gp + bj * HALF);
                    f32x4 s0 = {bf_lo(g.x), bf_hi(g.x), bf_lo(g.y), bf_hi(g.y)}, s1 = {bf_lo(g.z), bf_hi(g.z), bf_lo(g.w), bf_hi(g.w)};
                    if (br < 2) { const u32x4 h = *(const GAS u32x4*)(gn + bj * HALF);
                        const f32x4 d0 = {bf_lo(h.x), bf_hi(h.x), bf_lo(h.y), bf_hi(h.y)}, d1 = {bf_lo(h.z), bf_hi(h.z), bf_lo(h.w), bf_hi(h.w)};
#pragma unroll
                        for (int e = 0; e < 4; ++e) { s0[e] *= __builtin_amdgcn_rcpf(fmaxf(d0[e], 1e-30f)); s1[e] *= __builtin_amdgcn_rcpf(fmaxf(d1[e], 1e-30f)); }
                        acc[ai][bj][m][0] *= s0; acc[ai][bj][m][1] *= s1;
                    } else { const f32x4 v0 = acc[ai][bj][m][0] * s0, v1 = acc[ai][bj][m][1] * s1;
                        u32x4 w; w.x = cvt_pk_bf16(v0[0], v0[1]); w.y = cvt_pk_bf16(v0[2], v0[3]); w.z = cvt_pk_bf16(v1[0], v1[1]); w.w = cvt_pk_bf16(v1[2], v1[3]);
                        *(GAS u32x4*)(mp + bj * HALF) = w; } } }
    }
};
struct GateOrder {
    int G, c;
    __device__ bool next(int i, Unit& u) const { const int j = i / 3, br = i - 3 * j; const int pmn = c + j * G; if (pmn >= 512) return false; u.pm = pmn >> 2; u.pn = br * 4 + (pmn & 3); return true; }
    __device__ __forceinline__ void a_ready(const Unit&) const {}
    __device__ __forceinline__ void done(const Unit&) const {}
};
struct BranchOrder {
    int G, c;
    __device__ bool next(int i, Unit& u) const { const int j = i / 3, br = i - 3 * j; const int pmn = c + j * G; if (pmn >= 512) return false; u.pm = br * 128 + (pmn >> 2); u.pn = br * 4 + (pmn & 3); return true; }
    __device__ __forceinline__ void a_ready(const Unit&) const {}
    __device__ __forceinline__ void done(const Unit&) const {}
};
struct EpiResid {
    static constexpr bool PERM = true, AFTER_DRAIN = false, CHAIN = false;
    GAS float* out; GAS bf16_t* xb; GAS float* rowss;
    __device__ __forceinline__ void operator()(const f32x4 (&acc)[2][2][4][2], const Unit& u, int wr, int wc, int fr, int fq) const {
        const int row0 = u.pm * BM + wr * 64 + fr; const int col0 = u.pn * BM + wc * 32 + 8 * fq;
#pragma unroll
        for (int ai = 0; ai < 2; ++ai)
#pragma unroll
            for (int m = 0; m < 4; ++m) { const int row = row0 + ai * HALF + m * 16; const size_t off = (size_t)row * 1024 + col0; float q = 0.f;
#pragma unroll
                for (int bj = 0; bj < 2; ++bj) { const u32x4 xo = *(const GAS u32x4*)(xb + off + bj * HALF);
                    f32x4 v0 = acc[ai][bj][m][0], v1 = acc[ai][bj][m][1];
                    v0[0] += bf_lo(xo.x); v0[1] += bf_hi(xo.x); v0[2] += bf_lo(xo.y); v0[3] += bf_hi(xo.y); v1[0] += bf_lo(xo.z); v1[1] += bf_hi(xo.z); v1[2] += bf_lo(xo.w); v1[3] += bf_hi(xo.w);
                    if (out) { *(GAS f32x4*)(out + off + bj * HALF) = v0; *(GAS f32x4*)(out + off + bj * HALF + 4) = v1; }
                    u32x4 w; w.x = cvt_pk_bf16(v0[0], v0[1]); w.y = cvt_pk_bf16(v0[2], v0[3]); w.z = cvt_pk_bf16(v1[0], v1[1]); w.w = cvt_pk_bf16(v1[2], v1[3]);
                    if (!out) *(GAS u32x4*)(xb + off + bj * HALF) = w;
                    q += ((v0[0] * v0[0] + v0[1] * v0[1]) + (v0[2] * v0[2] + v0[3] * v0[3])) + ((v1[0] * v1[0] + v1[1] * v1[1]) + (v1[2] * v1[2] + v1[3] * v1[3])); }
                q += __shfl_xor(q, 16); q += __shfl_xor(q, 32);
                if (fq == 0 && !out) rowss[(size_t)row * 16 + u.pn * 4 + wc] = q; }
    }
};
struct EpiSwiGLU {
    static constexpr bool PERM = true, AFTER_DRAIN = false, CHAIN = false;
    GAS bf16_t* H; const GAS float* rowss;
    __device__ __forceinline__ void operator()(const f32x4 (&acc)[2][2][4][2], const Unit& u, int wr, int wc, int fr, int fq) const {
        const int row0 = u.pm * BM + wr * 64 + fr; const int col0 = (u.pn * BM + wc * 32 + 8 * fq) >> 1;
#pragma unroll
        for (int ai = 0; ai < 2; ++ai)
#pragma unroll
            for (int m = 0; m < 4; ++m) { const int row = row0 + ai * HALF + m * 16; const float rs = row_rs(rowss, row); GAS bf16_t* rowp = H + (size_t)row * 2816 + col0;
#pragma unroll
                for (int bj = 0; bj < 2; ++bj) { const f32x4 g = acc[ai][bj][m][0] * rs, uu = acc[ai][bj][m][1] * rs;
                    u32x2 w; w.x = cvt_pk_bf16(g[0] * sigmoid_f(g[0]) * uu[0], g[1] * sigmoid_f(g[1]) * uu[1]); w.y = cvt_pk_bf16(g[2] * sigmoid_f(g[2]) * uu[2], g[3] * sigmoid_f(g[3]) * uu[3]);
                    *(GAS u32x2*)(rowp + bj * (HALF / 2)) = w; } }
    }
};

template <class Epi, class Sched, bool ALIGN_EPI = false, bool SP2 = false>
__device__ __forceinline__ void gemm_phase(PG8_LAS unsigned char* lds, const Gemm g, const Sched& S, const Epi& E) {
    int tid_ = threadIdx.x; asm volatile("" : "+v"(tid_));
    const int tid = tid_, wid = __builtin_amdgcn_readfirstlane(tid >> 6), lane = tid & 63, wr = wid >> 2, wc = wid & 3, fr = lane & 15, fq = lane >> 4;
    const int K = g.K, nt = K / BK;
    unsigned voffA[2], voffB[2];
#pragma unroll
    for (int i = 0; i < 2; ++i) { int R, C; stage_rc(tid * 16 + i * 8192, R, C); const int Rb = Epi::PERM ? ((R & ~31) + perm32(R & 31)) : R;
        voffA[i] = (unsigned)(R * K + C) * 2u; voffB[i] = (unsigned)(Rb * K + C) * 2u; }
    const size_t kstep = (size_t)(BK * 2);
    const size_t hstep = (size_t)HALF * K * 2;
    const size_t tstep = 2 * hstep;
    const unsigned ldsw = (unsigned)wid * 1024u;
    const int aoff = lds_byte(wr * 64 + fr, fq * 8), boff = lds_byte(wc * 32 + fr, fq * 8);
#define PG8_SA(b, h) (((b) * 2 + (h)) * HTB)
#define PG8_SB(b, h) ((4 + (b) * 2 + (h)) * HTB)
#define PG8_STAGE(bufoff, gbase, voff) do { _Pragma("unroll") for (int _i = 0; _i < 2; ++_i) \
        __builtin_amdgcn_global_load_lds((const unsigned*)((const char*)(gbase) + (voff)[_i]), (PG8_LAS unsigned*)(lds + (bufoff) + ldsw + _i * 8192), 16, 0, 0); } while (0)
#define PG8_LDA(dst, b, h) do { _Pragma("unroll") for (int m = 0; m < 4; ++m) _Pragma("unroll") for (int k = 0; k < 2; ++k) dst[m][k] = *(const PG8_LAS bf16x8*)(lds + PG8_SA(b, h) + aoff + m * 2048 + k * 1024); } while (0)
#define PG8_LDB(dst, b, h) do { _Pragma("unroll") for (int n = 0; n < 2; ++n) _Pragma("unroll") for (int k = 0; k < 2; ++k) dst[n][k] = *(const PG8_LAS bf16x8*)(lds + PG8_SB(b, h) + boff + n * 2048 + k * 1024); } while (0)
#define PG8_MMA(ai, bj, At, Bt) do { __builtin_amdgcn_s_setprio(1); _Pragma("unroll") for (int m = 0; m < 4; ++m) _Pragma("unroll") for (int n = 0; n < 2; ++n) _Pragma("unroll") for (int k = 0; k < 2; ++k) \
        acc[ai][bj][m][n] = __builtin_amdgcn_mfma_f32_16x16x32_bf16(Bt[n][k], At[m][k], acc[ai][bj][m][n], 0, 0, 0); __builtin_amdgcn_s_setprio(0); } while (0)
#define PG8_WAIT_V(n) asm volatile("s_waitcnt vmcnt(" #n ")" ::: "memory")
#define PG8_WAIT_L(n) asm volatile("s_waitcnt lgkmcnt(" #n ")" ::: "memory")
#define PG8_BAR __builtin_amdgcn_s_barrier()
#define PG8_SCHED __builtin_amdgcn_sched_barrier(0)
    Unit cur, nxt; int ui = 0;
    if (!S.next(0, cur)) return;
    f32x4 acc[2][2][4][2];
#pragma unroll
    for (int a = 0; a < 2; ++a)
#pragma unroll
        for (int b = 0; b < 2; ++b)
#pragma unroll
            for (int m = 0; m < 4; ++m)
#pragma unroll
                for (int n = 0; n < 2; ++n) acc[a][b][m][n] = (f32x4){0.f, 0.f, 0.f, 0.f};
    bf16x8 At[4][2], B0[2][2], B1[2][2];
    const char* cA = (const char*)g.A + (size_t)cur.pm * tstep; const char* cB = (const char*)g.Bt + (size_t)cur.pn * tstep;
    S.a_ready(cur);
    if constexpr (SP2) {
        PG8_STAGE(PG8_SB(0, 0), cB, voffB); PG8_STAGE(PG8_SB(0, 1), cB + hstep, voffB); PG8_STAGE(PG8_SA(0, 0), cA, voffA); PG8_STAGE(PG8_SA(0, 1), cA + hstep, voffA);
        if (wr == 1) PG8_BAR;
        PG8_WAIT_V(2); PG8_BAR;
        PG8_STAGE(PG8_SB(1, 0), cB + kstep, voffB); PG8_STAGE(PG8_SA(1, 0), cA + kstep, voffA); PG8_STAGE(PG8_SB(1, 1), cB + hstep + kstep, voffB);
        PG8_WAIT_V(6); PG8_BAR;
    } else {
        PG8_STAGE(PG8_SB(0, 0), cB, voffB); PG8_STAGE(PG8_SA(0, 0), cA, voffA); PG8_STAGE(PG8_SB(0, 1), cB + hstep, voffB); PG8_STAGE(PG8_SA(0, 1), cA + hstep, voffA);
        if (wr == 1) PG8_BAR;
        PG8_WAIT_V(4); PG8_BAR;
        PG8_STAGE(PG8_SB(1, 0), cB + kstep, voffB); PG8_STAGE(PG8_SA(1, 0), cA + kstep, voffA); PG8_STAGE(PG8_SB(1, 1), cB + hstep + kstep, voffB);
        PG8_WAIT_V(6); PG8_BAR;
    }
    for (;;) {
        const bool has_next = S.next(ui + 1, nxt);
        const char* nA = has_next ? (const char*)g.A + (size_t)nxt.pm * tstep : cA; const char* nB = has_next ? (const char*)g.Bt + (size_t)nxt.pn * tstep : cB;
        for (int t = 0; t < nt; t += 2) {
            const bool last = (t == nt - 2);
            const char* a1 = cA + (size_t)(t + 1) * kstep;
            const char* a2 = last ? nA : cA + (size_t)(t + 2) * kstep; const char* b2 = last ? nB : cB + (size_t)(t + 2) * kstep;
            const char* a3 = a2 + kstep; const char* b3 = b2 + kstep;
            if (last && has_next) S.a_ready(nxt);
            if constexpr (SP2) {
            PG8_LDB(B0, 0, 0); PG8_LDB(B1, 0, 1); PG8_SCHED; PG8_LDA(At, 0, 0); PG8_STAGE(PG8_SA(1, 1), a1 + hstep, voffA);
            PG8_WAIT_V(8); PG8_WAIT_L(0); PG8_BAR; PG8_MMA(0, 0, At, B0); PG8_MMA(0, 1, At, B1); PG8_BAR; PG8_SCHED;
            PG8_LDA(At, 0, 1); PG8_STAGE(PG8_SB(0, 0), b2, voffB); PG8_STAGE(PG8_SB(0, 1), b2 + hstep, voffB); PG8_STAGE(PG8_SA(0, 0), a2, voffA);
            PG8_WAIT_V(8); PG8_WAIT_L(0); PG8_BAR; PG8_MMA(1, 0, At, B0); PG8_MMA(1, 1, At, B1); PG8_BAR; PG8_SCHED;
            PG8_LDB(B0, 1, 0); PG8_LDB(B1, 1, 1); PG8_SCHED; PG8_LDA(At, 1, 0); PG8_STAGE(PG8_SA(0, 1), a2 + hstep, voffA);
            PG8_WAIT_V(8); PG8_WAIT_L(0); PG8_BAR; PG8_MMA(0, 0, At, B0); PG8_MMA(0, 1, At, B1); PG8_BAR; PG8_SCHED;
            PG8_LDA(At, 1, 1); PG8_STAGE(PG8_SB(1, 0), b3, voffB); PG8_STAGE(PG8_SB(1, 1), b3 + hstep, voffB); PG8_STAGE(PG8_SA(1, 0), a3, voffA);
            PG8_WAIT_V(8); PG8_WAIT_L(0); PG8_BAR; PG8_MMA(1, 0, At, B0); PG8_MMA(1, 1, At, B1); PG8_BAR; PG8_SCHED;
            } else {
            PG8_LDB(B0, 0, 0); PG8_SCHED; PG8_LDA(At, 0, 0); PG8_STAGE(PG8_SA(1, 1), a1 + hstep, voffA);
            PG8_WAIT_L(8); PG8_BAR; PG8_WAIT_L(0); PG8_MMA(0, 0, At, B0); PG8_BAR; PG8_SCHED;
            PG8_LDB(B1, 0, 1); PG8_STAGE(PG8_SB(0, 0), b2, voffB);
            PG8_BAR; PG8_WAIT_L(0); PG8_MMA(0, 1, At, B1); PG8_BAR;
            PG8_LDA(At, 0, 1); PG8_STAGE(PG8_SA(0, 0), a2, voffA);
            PG8_BAR; PG8_WAIT_L(0); PG8_MMA(1, 0, At, B0); PG8_BAR; PG8_SCHED;
            PG8_STAGE(PG8_SB(0, 1), b2 + hstep, voffB);
            PG8_WAIT_V(6); PG8_BAR; PG8_MMA(1, 1, At, B1); PG8_BAR;
            PG8_LDB(B0, 1, 0); PG8_SCHED; PG8_LDA(At, 1, 0); PG8_STAGE(PG8_SA(0, 1), a2 + hstep, voffA);
            PG8_WAIT_L(8); PG8_BAR; PG8_WAIT_L(0); PG8_MMA(0, 0, At, B0); PG8_BAR; PG8_SCHED;
            PG8_LDB(B1, 1, 1); PG8_STAGE(PG8_SB(1, 0), b3, voffB);
            PG8_BAR; PG8_WAIT_L(0); PG8_MMA(0, 1, At, B1); PG8_BAR;
            PG8_LDA(At, 1, 1); PG8_STAGE(PG8_SA(1, 0), a3, voffA);
            PG8_BAR; PG8_WAIT_L(0); PG8_MMA(1, 0, At, B0); PG8_BAR; PG8_SCHED;
            PG8_STAGE(PG8_SB(1, 1), b3 + hstep, voffB);
            PG8_WAIT_V(6); PG8_BAR; PG8_MMA(1, 1, At, B1); PG8_BAR;
            }
        }
        if constexpr (ALIGN_EPI) { if (wr == 0) PG8_BAR; }
        if constexpr (!Epi::AFTER_DRAIN) { E(acc, cur, wr, wc, fr, fq); S.done(cur); }
        if (!has_next) break;
        bool keep_ = false; if constexpr (Epi::CHAIN) keep_ = E.keep(cur);
        if (!keep_) {
#pragma unroll
        for (int a = 0; a < 2; ++a)
#pragma unroll
            for (int b = 0; b < 2; ++b)
#pragma unroll
                for (int m = 0; m < 4; ++m)
#pragma unroll
                    for (int n = 0; n < 2; ++n) acc[a][b][m][n] = (f32x4){0.f, 0.f, 0.f, 0.f};
        }
        cur = nxt; cA = nA; cB = nB; ++ui;
        if constexpr (ALIGN_EPI) { if (wr == 1) PG8_BAR; }
    }
    PG8_WAIT_V(0);
    if constexpr (!ALIGN_EPI) { if (wr == 0) PG8_BAR; }
    PG8_BAR;
    if constexpr (Epi::AFTER_DRAIN) { E.fused(acc, cur, wr, wc, fr, fq, lds, wid, lane); S.done(cur); }
#undef PG8_SA
#undef PG8_SB
#undef PG8_STAGE
#undef PG8_LDA
#undef PG8_LDB
#undef PG8_MMA
#undef PG8_WAIT_V
#undef PG8_WAIT_L
#undef PG8_BAR
#undef PG8_SCHED
}
}
namespace att {
#define LAS __attribute__((address_space(3)))
typedef unsigned short bf16_t;
typedef short bf16x8 __attribute__((ext_vector_type(8)));
typedef short s16x4 __attribute__((ext_vector_type(4)));
typedef short v4i16_t __attribute__((ext_vector_type(4)));
typedef float f32x16 __attribute__((ext_vector_type(16)));
typedef float f32x4 __attribute__((ext_vector_type(4)));
typedef unsigned u32x4 __attribute__((ext_vector_type(4)));
typedef unsigned u32x2 __attribute__((ext_vector_type(2)));
constexpr int SEQ = 2048, PITCH = 512, MROWS = 32768;
constexpr size_t BUF = (size_t)MROWS * 512;
constexpr float LOG2E = 1.4426950408889634f, C2 = 0.125f * LOG2E;
constexpr int TAB_OFF = 65536, BC_OFF = 131072 + 512, FL_OFF = BC_OFF + 64, PRM_OFF = 131072 + 4096;
using pg8::cvt_pk_bf16; using pg8::bf_lo; using pg8::bf_hi;
#define MFMA32(a, b, c) __builtin_amdgcn_mfma_f32_32x32x16_bf16((a), (b), (c), 0, 0, 0)
__device__ __forceinline__ s16x4 vtr(const LAS unsigned char* p) { return __builtin_bit_cast(s16x4, __builtin_amdgcn_ds_read_tr16_b64_v4i16((LAS v4i16_t*)p)); }
__device__ __forceinline__ u32x4 scale8(u32x4 v, float s) { u32x4 o; o.x = cvt_pk_bf16(bf_lo(v.x) * s, bf_hi(v.x) * s); o.y = cvt_pk_bf16(bf_lo(v.y) * s, bf_hi(v.y) * s); o.z = cvt_pk_bf16(bf_lo(v.z) * s, bf_hi(v.z) * s); o.w = cvt_pk_bf16(bf_lo(v.w) * s, bf_hi(v.w) * s); return o; }
__device__ __forceinline__ bf16x8 pack8(const f32x16& p, int s) { u32x4 w; w.x = cvt_pk_bf16(p[8 * s], p[8 * s + 1]); w.y = cvt_pk_bf16(p[8 * s + 2], p[8 * s + 3]); w.z = cvt_pk_bf16(p[8 * s + 4], p[8 * s + 5]); w.w = cvt_pk_bf16(p[8 * s + 6], p[8 * s + 7]); return __builtin_bit_cast(bf16x8, w); }
__device__ __forceinline__ float wave_sum(float v) {
#pragma unroll
    for (int o = 1; o < 64; o <<= 1) v += __shfl_xor(v, o);
    return v; }
struct AttnArgs { GAS bf16_t* qkv; GAS bf16_t* obase; const GAS float* ss; const GAS float* qk_g_diff; const GAS float* lambda_qk; const GAS float* subln_g; const GAS float* qk_g_ch; const GAS float* rel_bias; float lam_init; };

__device__ __forceinline__ void qkt(f32x16& p0, f32x16& p1, const LAS unsigned char* kimg, const bf16x8* qr, int r32, int hi, float cinit = 0.f) {
    const LAS unsigned char* kb = kimg + hi * 1024 + r32 * 16;
#pragma unroll
    for (int r = 0; r < 16; ++r) { p0[r] = cinit; p1[r] = cinit; }
    bf16x8 kf[8];
#pragma unroll
    for (int d0 = 0; d0 < 4; ++d0) { kf[2 * d0] = *(const LAS bf16x8*)(kb + d0 * 2048); kf[2 * d0 + 1] = *(const LAS bf16x8*)(kb + d0 * 2048 + 512); }
    __builtin_amdgcn_sched_barrier(0);
#pragma unroll
    for (int d0 = 0; d0 < 4; ++d0) { p0 = MFMA32(kf[2 * d0], qr[d0], p0); p1 = MFMA32(kf[2 * d0 + 1], qr[d0], p1); }
    __builtin_amdgcn_sched_barrier(0);
}
template <int NB> __device__ __forceinline__ void pv(f32x16* o, const LAS unsigned char* vimg, int vl, const f32x16& p0, const f32x16& p1) {
    const bf16x8 pf[4] = {pack8(p0, 0), pack8(p0, 1), pack8(p1, 0), pack8(p1, 1)};
    s16x4 lo[2][4], hh[2][4];
#pragma unroll
    for (int ks = 0; ks < 4; ++ks) { const LAS unsigned char* vp = vimg + vl + ks * 1024; lo[0][ks] = vtr(vp); hh[0][ks] = vtr(vp + 512); }
#pragma unroll
    for (int blk = 0; blk < NB; ++blk) {
        if (blk + 1 < NB) {
#pragma unroll
            for (int ks = 0; ks < 4; ++ks) { const LAS unsigned char* vp = vimg + vl + (blk + 1) * 4096 + ks * 1024; lo[(blk + 1) & 1][ks] = vtr(vp); hh[(blk + 1) & 1][ks] = vtr(vp + 512); } }
        __builtin_amdgcn_sched_barrier(0);
#pragma unroll
        for (int ks = 0; ks < 4; ++ks) { const s16x4 a = lo[blk & 1][ks], b = hh[blk & 1][ks];
            const bf16x8 vf = (bf16x8){a[0], a[1], a[2], a[3], b[0], b[1], b[2], b[3]};
            o[blk] = MFMA32(vf, pf[ks], o[blk]); }
        __builtin_amdgcn_sched_barrier(0);
    }
}
__device__ __forceinline__ void qkt_half(f32x16& p, const LAS unsigned char* kimg, const bf16x8* qr, int r32, int hi, float cinit, int half) {
    const LAS unsigned char* kb = kimg + hi * 1024 + r32 * 16 + half * 512;
#pragma unroll
    for (int r = 0; r < 16; ++r) p[r] = cinit;
    bf16x8 kf[4];
#pragma unroll
    for (int d0 = 0; d0 < 4; ++d0) kf[d0] = *(const LAS bf16x8*)(kb + d0 * 2048);
#pragma unroll
    for (int d0 = 0; d0 < 4; ++d0) p = MFMA32(kf[d0], qr[d0], p);
}
template <int NB> __device__ __forceinline__ void pv_half(f32x16* o, const LAS unsigned char* vimg, int vl, const f32x16& p, int half) {
    const bf16x8 pf[2] = {pack8(p, 0), pack8(p, 1)};
#pragma unroll
    for (int blk = 0; blk < NB; ++blk) { s16x4 lo[2], hh[2];
#pragma unroll
        for (int ks = 0; ks < 2; ++ks) { const LAS unsigned char* vp = vimg + vl + blk * 4096 + (2 * half + ks) * 1024; lo[ks] = vtr(vp); hh[ks] = vtr(vp + 512); }
#pragma unroll
        for (int ks = 0; ks < 2; ++ks) { const bf16x8 vf = (bf16x8){lo[ks][0], lo[ks][1], lo[ks][2], lo[ks][3], hh[ks][0], hh[ks][1], hh[ks][2], hh[ks][3]};
            o[blk] = MFMA32(vf, pf[ks], o[blk]); } }
}
template <int NB> __device__ __forceinline__ void store_o(GAS bf16_t* orow, const f32x16* o, int hi) {
#pragma unroll
    for (int blk = 0; blk < NB; ++blk)
#pragma unroll
        for (int i = 0; i < 4; ++i) { u32x2 w; w.x = cvt_pk_bf16(o[blk][4 * i], o[blk][4 * i + 1]); w.y = cvt_pk_bf16(o[blk][4 * i + 2], o[blk][4 * i + 3]);
            *(GAS u32x2*)(orow + blk * 32 + 8 * i + 4 * hi) = w; }
}

template <int VAR, bool FIX> __device__ __forceinline__ void unit_ac(const AttnArgs& A, int b, int h, int qb, LAS unsigned char* lds, float shift) {
    int tid_ = threadIdx.x; asm volatile("" : "+v"(tid_));
    const int tid = tid_, lane = tid & 63, r32 = lane & 31, hi = lane >> 5; const int wid = __builtin_amdgcn_readfirstlane(tid >> 6);
    const size_t rowbase = (size_t)b * SEQ; const int q0 = qb * 256;
    if (wid < 4) __builtin_amdgcn_s_setprio(2); else __builtin_amdgcn_s_setprio(0);
    GAS bf16_t* qkv_ = A.qkv; const GAS float* ss_ = A.ss; asm volatile("" : "+s"(qkv_), "+s"(ss_));
    GAS bf16_t* Qb = qkv_ + (VAR == 0 ? 0 : 2) * BUF; const GAS bf16_t* Kb = qkv_ + (VAR == 0 ? 3 : 7) * BUF; const GAS bf16_t* Vb = qkv_ + (VAR == 0 ? 4 : 8) * BUF;
    const GAS float* ssq = ss_ + (size_t)1 * MROWS * 16; const GAS float* ssk = ss_ + (size_t)3 * MROWS * 16;
    const int qrow = q0 + wid * 32 + r32;
    bf16x8 qr[4];
    { const GAS bf16_t* qp = Qb + (rowbase + qrow) * PITCH + h * 64; float qs = C2;
      if (VAR == 2) { const GAS float* s = ssq + (rowbase + qrow) * 16 + 2 * h; qs = C2 * __builtin_amdgcn_rsqf((s[0] + s[1]) * (1.0f / 64.0f) + 1e-6f); }
#pragma unroll
      for (int d0 = 0; d0 < 4; ++d0) { const u32x4 raw = *(const GAS u32x4*)(qp + d0 * 16 + hi * 8); u32x4 w;
          if (VAR == 2) { const LAS float* g = (const LAS float*)(lds + PRM_OFF) + 96 + d0 * 16 + hi * 8; const f32x4 a0 = *(const LAS f32x4*)g * qs, a1 = *(const LAS f32x4*)(g + 4) * qs;
              w.x = cvt_pk_bf16(bf_lo(raw.x) * a0[0], bf_hi(raw.x) * a0[1]); w.y = cvt_pk_bf16(bf_lo(raw.y) * a0[2], bf_hi(raw.y) * a0[3]);
              w.z = cvt_pk_bf16(bf_lo(raw.z) * a1[0], bf_hi(raw.z) * a1[1]); w.w = cvt_pk_bf16(bf_lo(raw.w) * a1[2], bf_hi(raw.w) * a1[3]); }
          else w = scale8(raw, qs);
          qr[d0] = __builtin_bit_cast(bf16x8, w); } }
    const int t_hi = 4 * qb + 3, t_lo = (VAR == 0) ? 0 : ((4 * qb - 8) > 0 ? (4 * qb - 8) : 0), nT = t_hi - t_lo + 1;
    const int tw = 4 * qb + (wid >> 1);
    if (VAR == 2) { LAS float* T = (LAS float*)(lds + TAB_OFF);
        for (int j = tid; j < 640; j += 512) { int d = j - 63; d = d < -128 ? -128 : (d > 128 ? 128 : d); T[j] = A.rel_bias[h * 257 + d + 128] * LOG2E; } }
    const GAS bf16_t* ksrc = Kb + (rowbase + lane) * PITCH + h * 64 + wid * 8;
    const GAS bf16_t* vsrc = Vb + (rowbase + 16 * (wid & 3) + (lane >> 2)) * PITCH + h * 64 + (wid >> 2) * 32 + (lane & 3) * 8;
    const GAS float* ksst = ssk + (rowbase + lane) * 16 + 2 * h;
    const int sdst = wid * 1024 + lane * 16;
    u32x4 kreg, vreg;
    float ks0 = 0.f, ks1 = 0.f;
#define LOAD_T(t) do { kreg = *(const GAS u32x4*)(ksrc + (size_t)(t) * 64 * PITCH); vreg = *(const GAS u32x4*)(vsrc + (size_t)(t) * 64 * PITCH); \
        if (VAR == 2) { const GAS float* s_ = ksst + (size_t)(t) * 64 * 16; ks0 = s_[0]; ks1 = s_[1]; } } while (0)
#define WRITE_T(st) do { if (VAR == 2) kreg = scale8(kreg, __builtin_amdgcn_rsqf((ks0 + ks1) * (1.0f / 64.0f) + 1e-6f)); \
        *(LAS u32x4*)(lds + (st) * 16384 + sdst) = kreg; *(LAS u32x4*)(lds + (st) * 16384 + 8192 + sdst) = vreg; } while (0)
#define TILE(i) ((VAR == 0) ? (t_hi - (i)) : (t_lo + (i)))
    const int vl = (4 * hi + ((lane & 15) >> 2)) * 64 + ((lane >> 4) & 1) * 32 + (lane & 3) * 8;
    f32x16 o[2]; o[0] = f32x16{}; o[1] = f32x16{};
    float m_run = -1e30f, l_run = 0.f, pc = 1.0f;
    LOAD_T(TILE(0)); WRITE_T(0); __syncthreads();
    for (int i = 0; i < nT; ++i) {
        const int t = TILE(i); const int st = i & 1;
        if (i + 1 < nT) LOAD_T(TILE(i + 1));
        const bool wdone = (VAR == 0) && (__builtin_amdgcn_ballot_w64(pc != 0.0f) == 0ull);
        const bool active = (VAR == 0) ? (t <= tw && !wdone) : (t <= tw && t >= tw - 8);
        if (active) {
            f32x16 p0, p1;
            if (VAR == 2 && FIX) {
                const LAS float* T = (const LAS float*)(lds + TAB_OFF);
                const bool far = (t <= tw - 3);
                const LAS unsigned char* kimg = lds + st * 16384; const LAS unsigned char* vimg = lds + st * 16384 + 8192;
                const LAS float* Tq = T + (qrow + 63 - 64 * t - 4 * hi);
                float sum0 = 0.f, sum1 = 0.f;
                if (far) {
                    const float ci = T[639] - shift;
                    qkt_half(p0, kimg, qr, r32, hi, ci, 0); qkt_half(p1, kimg, qr, r32, hi, ci, 1);
#pragma unroll
                    for (int r = 0; r < 16; ++r) { p0[r] = __builtin_amdgcn_exp2f(p0[r]); sum0 += p0[r]; }
                    pv_half<2>(o, vimg, vl, p0, 0);
#pragma unroll
                    for (int r = 0; r < 16; ++r) { p1[r] = __builtin_amdgcn_exp2f(p1[r]); sum1 += p1[r]; }
                    pv_half<2>(o, vimg, vl, p1, 1);
                } else {
                    qkt_half(p0, kimg, qr, r32, hi, -shift, 0); qkt_half(p1, kimg, qr, r32, hi, -shift, 1);
#pragma unroll
                    for (int r = 0; r < 16; ++r) { const int kk = (r & 3) + 8 * (r >> 2); p0[r] = __builtin_amdgcn_exp2f(p0[r] + Tq[-kk]); sum0 += p0[r]; }
                    pv_half<2>(o, vimg, vl, p0, 0);
#pragma unroll
                    for (int r = 0; r < 16; ++r) { const int kk = (r & 3) + 8 * (r >> 2); p1[r] = __builtin_amdgcn_exp2f(p1[r] + Tq[-kk - 32]); sum1 += p1[r]; }
                    pv_half<2>(o, vimg, vl, p1, 1);
                }
                l_run += sum0 + sum1;
            } else if (VAR == 2) {
                qkt(p0, p1, lds + st * 16384, qr, r32, hi);
                const LAS float* T = (const LAS float*)(lds + TAB_OFF) + (qrow + 63 - 64 * t - 4 * hi);
#pragma unroll
                for (int r = 0; r < 16; ++r) { const int kk = (r & 3) + 8 * (r >> 2); p0[r] += T[-kk]; p1[r] += T[-kk - 32]; }
                float mx = p0[0];
#pragma unroll
                for (int r = 1; r < 16; ++r) mx = fmaxf(mx, p0[r]);
#pragma unroll
                for (int r = 0; r < 16; ++r) mx = fmaxf(mx, p1[r]);
                mx = fmaxf(mx, __shfl_xor(mx, 32));
                const float mn = fmaxf(m_run, mx), alpha = __builtin_amdgcn_exp2f(m_run - mn); m_run = mn;
                float sum = 0.f;
#pragma unroll
                for (int r = 0; r < 16; ++r) { p0[r] = __builtin_amdgcn_exp2f(p0[r] - mn); p1[r] = __builtin_amdgcn_exp2f(p1[r] - mn); sum += p0[r] + p1[r]; }
                l_run = l_run * alpha + sum;
#pragma unroll
                for (int r = 0; r < 16; ++r) { o[0][r] *= alpha; o[1][r] *= alpha; }
            } else {
                qkt(p0, p1, lds + st * 16384, qr, r32, hi);
                const bool diag = (t == tw); const int qd = (wid & 1) * 32 + r32;
                float G[16];
#pragma unroll
                for (int p = 0; p < 2; ++p)
#pragma unroll
                    for (int i4 = 0; i4 < 4; ++i4) { float rr[4];
#pragma unroll
                        for (int j = 0; j < 4; ++j) { const float z = p ? p1[4 * i4 + j] : p0[4 * i4 + j]; float rv = __builtin_amdgcn_rcpf(1.0f + __builtin_amdgcn_exp2f(fminf(z, 80.f)));
                            if (diag) { const int kk = 32 * p + 8 * i4 + 4 * hi + j; if (kk >= qd) rv = 1.0f; }
                            rr[j] = rv; }
                        const float sc = rr[3], sb = rr[3] * rr[2], sa = sb * rr[1], R = sa * rr[0];
                        const float w0 = (1.0f - rr[0]) * sa, w1 = (1.0f - rr[1]) * sb, w2 = (1.0f - rr[2]) * sc, w3 = (1.0f - rr[3]);
                        if (p) { p1[4 * i4] = w0; p1[4 * i4 + 1] = w1; p1[4 * i4 + 2] = w2; p1[4 * i4 + 3] = w3; } else { p0[4 * i4] = w0; p0[4 * i4 + 1] = w1; p0[4 * i4 + 2] = w2; p0[4 * i4 + 3] = w3; }
                        const float Ro = __shfl_xor(R, 32);
                        G[2 * (4 * p + i4)] = hi ? Ro : R; G[2 * (4 * p + i4) + 1] = hi ? R : Ro; }
                float Ee[8], Eo[8]; Eo[7] = pc;
#pragma unroll
                for (int q = 7; q >= 0; --q) { Ee[q] = Eo[q] * G[2 * q + 1]; if (q > 0) Eo[q - 1] = Ee[q] * G[2 * q]; }
                pc = Ee[0] * G[0];
#pragma unroll
                for (int q = 0; q < 8; ++q) { const float e = hi ? Eo[q] : Ee[q];
#pragma unroll
                    for (int j = 0; j < 4; ++j) { if (q < 4) p0[4 * q + j] *= e; else p1[4 * (q - 4) + j] *= e; } }
            }
            if (!(VAR == 2 && FIX)) pv<2>(o, lds + st * 16384 + 8192, vl, p0, p1);
        }
        if (i + 1 < nT) WRITE_T(st ^ 1);
        if (VAR == 0) { const bool wd2 = (__builtin_amdgcn_ballot_w64(pc != 0.0f) == 0ull); if (lane == 0) ((LAS unsigned*)(lds + FL_OFF))[st * 8 + wid] = wd2 ? 1u : 0u; }
        __syncthreads();
        if (VAR == 0) { const LAS unsigned* fl = (const LAS unsigned*)(lds + FL_OFF) + st * 8; const unsigned all = fl[0] & fl[1] & fl[2] & fl[3] & fl[4] & fl[5] & fl[6] & fl[7];
            if (__builtin_amdgcn_readfirstlane(all)) break; }
    }
    if (VAR == 2) { const float lt = l_run + __shfl_xor(l_run, 32), inv = __builtin_amdgcn_rcpf(lt);
#pragma unroll
        for (int r = 0; r < 16; ++r) { o[0][r] *= inv; o[1][r] *= inv; } }
    store_o<2>(A.obase + (VAR == 0 ? 0 : 2) * BUF + (rowbase + qrow) * PITCH + h * 64, o, hi);
#undef LOAD_T
#undef WRITE_T
#undef TILE
}

__device__ __forceinline__ void unit_a4(const AttnArgs& A, int b, int hg, int c, LAS unsigned char* lds) {
    int tid_ = threadIdx.x; asm volatile("" : "+v"(tid_));
    const int tid = tid_, lane = tid & 63, r32 = lane & 31, hi = lane >> 5; const int wid = __builtin_amdgcn_readfirstlane(tid >> 6);
    const int hh = wid >> 1, h = 4 * hg + hh;
    const size_t rowbase = (size_t)b * SEQ;
    if (wid < 4) __builtin_amdgcn_s_setprio(2); else __builtin_amdgcn_s_setprio(0);
    GAS bf16_t* qkv_ = A.qkv; asm volatile("" : "+s"(qkv_));
    GAS bf16_t* Qb = qkv_; const GAS bf16_t* Kb = qkv_ + 3 * BUF; const GAS bf16_t* Vb = qkv_ + 4 * BUF;
    const int qd = (wid & 1) * 32 + r32, qrow = 64 * c + qd;
    bf16x8 qr[4];
    { const GAS bf16_t* qp = Qb + (rowbase + qrow) * PITCH + h * 64;
#pragma unroll
      for (int d0 = 0; d0 < 4; ++d0) qr[d0] = __builtin_bit_cast(bf16x8, scale8(*(const GAS u32x4*)(qp + d0 * 16 + hi * 8), C2)); }
    const GAS bf16_t* ksrc = Kb + (rowbase + lane) * PITCH + hg * 256 + wid * 8;
    const GAS bf16_t* vsrc = Vb + (rowbase + 16 * (wid & 3) + (lane >> 2)) * PITCH + hg * 256 + (wid >> 2) * 32 + (lane & 3) * 8;
    const int sdst = wid * 1024 + lane * 16;
    u32x4 kr[4], vr[4];
#define LOAD_T(t) do { const size_t o_ = (size_t)(t) * 64 * PITCH; _Pragma("unroll") for (int j = 0; j < 4; ++j) { kr[j] = *(const GAS u32x4*)(ksrc + o_ + j * 64); vr[j] = *(const GAS u32x4*)(vsrc + o_ + j * 64); } } while (0)
#define WRITE_T(st) do { _Pragma("unroll") for (int j = 0; j < 4; ++j) { *(LAS u32x4*)(lds + (st) * 65536 + j * 8192 + sdst) = kr[j]; *(LAS u32x4*)(lds + (st) * 65536 + 32768 + j * 8192 + sdst) = vr[j]; } } while (0)
    const int vl = (4 * hi + ((lane & 15) >> 2)) * 64 + ((lane >> 4) & 1) * 32 + (lane & 3) * 8;
    f32x16 o[2]; o[0] = f32x16{}; o[1] = f32x16{};
    float pc = 1.0f;
    const int nT = c + 1;
    LOAD_T(c); WRITE_T(0); __syncthreads();
    for (int i = 0; i < nT; ++i) {
        const int t = c - i; const int st = i & 1;
        if (i + 1 < nT) LOAD_T(t - 1);
        const bool wdone = (__builtin_amdgcn_ballot_w64(pc != 0.0f) == 0ull);
        if (!wdone) {
            f32x16 p0, p1; qkt(p0, p1, lds + st * 65536 + hh * 8192, qr, r32, hi);
            const bool diag = (i == 0);
            float G[16];
#pragma unroll
            for (int p = 0; p < 2; ++p)
#pragma unroll
                for (int i4 = 0; i4 < 4; ++i4) { float rr[4];
#pragma unroll
                    for (int j = 0; j < 4; ++j) { const float z = p ? p1[4 * i4 + j] : p0[4 * i4 + j]; float rv = __builtin_amdgcn_rcpf(1.0f + __builtin_amdgcn_exp2f(fminf(z, 80.f)));
                        if (diag) { const int kk = 32 * p + 8 * i4 + 4 * hi + j; if (kk >= qd) rv = 1.0f; }
                        rr[j] = rv; }
                    const float sc = rr[3], sb = rr[3] * rr[2], sa = sb * rr[1], R = sa * rr[0];
                    const float w0 = (1.0f - rr[0]) * sa, w1 = (1.0f - rr[1]) * sb, w2 = (1.0f - rr[2]) * sc, w3 = (1.0f - rr[3]);
                    if (p) { p1[4 * i4] = w0; p1[4 * i4 + 1] = w1; p1[4 * i4 + 2] = w2; p1[4 * i4 + 3] = w3; } else { p0[4 * i4] = w0; p0[4 * i4 + 1] = w1; p0[4 * i4 + 2] = w2; p0[4 * i4 + 3] = w3; }
                    const float Ro = __shfl_xor(R, 32);
                    G[2 * (4 * p + i4)] = hi ? Ro : R; G[2 * (4 * p + i4) + 1] = hi ? R : Ro; }
            float Ee[8], Eo[8]; Eo[7] = pc;
#pragma unroll
            for (int q = 7; q >= 0; --q) { Ee[q] = Eo[q] * G[2 * q + 1]; if (q > 0) Eo[q - 1] = Ee[q] * G[2 * q]; }
            pc = Ee[0] * G[0];
#pragma unroll
            for (int q = 0; q < 8; ++q) { const float e = hi ? Eo[q] : Ee[q];
#pragma unroll
                for (int j = 0; j < 4; ++j) { if (q < 4) p0[4 * q + j] *= e; else p1[4 * (q - 4) + j] *= e; } }
            pv<2>(o, lds + st * 65536 + 32768 + hh * 8192, vl, p0, p1);
        }
        if (i + 1 < nT) WRITE_T(st ^ 1);
        { const bool wd2 = (__builtin_amdgcn_ballot_w64(pc != 0.0f) == 0ull); if (lane == 0) ((LAS unsigned*)(lds + FL_OFF))[st * 8 + wid] = wd2 ? 1u : 0u; }
        __syncthreads();
        { const LAS unsigned* fl = (const LAS unsigned*)(lds + FL_OFF) + st * 8; const unsigned all = fl[0] & fl[1] & fl[2] & fl[3] & fl[4] & fl[5] & fl[6] & fl[7];
          if (__builtin_amdgcn_readfirstlane(all)) break; }
    }
    store_o<2>(A.obase + (rowbase + qrow) * PITCH + h * 64, o, hi);
#undef LOAD_T
#undef WRITE_T
}

__device__ __forceinline__ void unit_b(const AttnArgs& A, int b, int h, int qb, LAS unsigned char* lds) {
    int tid_ = threadIdx.x; asm volatile("" : "+v"(tid_));
    const int tid = tid_, lane = tid & 63, r32 = lane & 31, hi = lane >> 5; const int wid = __builtin_amdgcn_readfirstlane(tid >> 6);
    const int mp = wid >> 2, g4 = wid & 3;
    if (wid < 4) __builtin_amdgcn_s_setprio(2); else __builtin_amdgcn_s_setprio(0);
    const size_t rowbase = (size_t)b * SEQ; const int q0 = qb * 128;
    GAS bf16_t* qkv_ = A.qkv; const GAS float* ss_ = A.ss; asm volatile("" : "+s"(qkv_), "+s"(ss_));
    GAS bf16_t* Qb = qkv_ + 1 * BUF; const GAS bf16_t* Kb = qkv_ + 5 * BUF; const GAS bf16_t* Vb = qkv_ + 6 * BUF;
    const GAS float* ssq = ss_; const GAS float* ssk = ss_ + (size_t)2 * MROWS * 16;
    const int qrow = q0 + g4 * 32 + r32;
    const LAS float* prm = (const LAS float*)(lds + PRM_OFF); const float lam = prm[0], M0 = prm[1];
    bf16x8 qr[4];
    { const GAS bf16_t* qp = Qb + (rowbase + qrow) * PITCH + h * 128 + mp * 64; const GAS float* s = ssq + (rowbase + qrow) * 16 + 4 * h + 2 * mp;
      const float qs = C2 * __builtin_amdgcn_rsqf((s[0] + s[1]) * (1.0f / 64.0f) + 1e-6f);
#pragma unroll
      for (int d0 = 0; d0 < 4; ++d0) { const u32x4 raw = *(const GAS u32x4*)(qp + d0 * 16 + hi * 8); u32x4 w;
          const LAS float* g = prm + 32 + d0 * 16 + hi * 8; const f32x4 a0 = *(const LAS f32x4*)g * qs, a1 = *(const LAS f32x4*)(g + 4) * qs;
          w.x = cvt_pk_bf16(bf_lo(raw.x) * a0[0], bf_hi(raw.x) * a0[1]); w.y = cvt_pk_bf16(bf_lo(raw.y) * a0[2], bf_hi(raw.y) * a0[3]);
          w.z = cvt_pk_bf16(bf_lo(raw.z) * a1[0], bf_hi(raw.z) * a1[1]); w.w = cvt_pk_bf16(bf_lo(raw.w) * a1[2], bf_hi(raw.w) * a1[3]);
          qr[d0] = __builtin_bit_cast(bf16x8, w); } }
    const int nT = 2 * qb + 2; const int tw = 2 * qb + (g4 >> 1);
    const float slope2 = LOG2E * exp2f(-2.0f * (float)(h + 1));
    const GAS bf16_t* ksrc = Kb + (rowbase + lane) * PITCH + h * 128 + wid * 8;
    const GAS bf16_t* vsrc0 = Vb + (rowbase + 16 * (wid & 3) + (lane >> 2)) * PITCH + h * 128 + (wid >> 2) * 32 + (lane & 3) * 8;
    const GAS float* ksst = ssk + (rowbase + lane) * 16 + 4 * h;
    const int sdst = wid * 1024 + lane * 16;
    u32x4 k0r, k1r, v0r, v1r;
    f32x4 kss = {0.f, 0.f, 0.f, 0.f};
#define LOAD_T(t) do { const size_t o_ = (size_t)(t) * 64 * PITCH; k0r = *(const GAS u32x4*)(ksrc + o_); k1r = *(const GAS u32x4*)(ksrc + o_ + 64); v0r = *(const GAS u32x4*)(vsrc0 + o_); v1r = *(const GAS u32x4*)(vsrc0 + o_ + 64); \
        kss = *(const GAS f32x4*)(ksst + (size_t)(t) * 64 * 16); } while (0)
#define WRITE_T(st) do { LAS unsigned char* d_ = lds + (st) * 32768 + sdst; k0r = scale8(k0r, __builtin_amdgcn_rsqf((kss[0] + kss[1]) * (1.0f / 64.0f) + 1e-6f)); k1r = scale8(k1r, __builtin_amdgcn_rsqf((kss[2] + kss[3]) * (1.0f / 64.0f) + 1e-6f)); *(LAS u32x4*)(d_) = k0r; *(LAS u32x4*)(d_ + 8192) = k1r; *(LAS u32x4*)(d_ + 16384) = v0r; *(LAS u32x4*)(d_ + 16384 + 8192) = v1r; } while (0)
    const int vl = (4 * hi + ((lane & 15) >> 2)) * 64 + ((lane >> 4) & 1) * 32 + (lane & 3) * 8;
    f32x16 o[4]; o[0] = f32x16{}; o[1] = f32x16{}; o[2] = f32x16{}; o[3] = f32x16{};
    float l_run = 0.f;
    const int tfirst = [&] { const float dcut = 150.0f / slope2; const float x = ((float)(q0 - 63) - dcut) * (1.0f / 64.0f); int t0 = (x > 0.f) ? (int)x + 1 : 0; return t0 < nT - 1 ? t0 : nT - 1; }();
    LOAD_T(tfirst); WRITE_T(tfirst & 1); __syncthreads();
    for (int t = tfirst; t < nT; ++t) {
        const int st = t & 1;
        if (t + 1 < nT) LOAD_T(t + 1);
        if (t <= tw) {
            f32x16 p0, p1;
            const LAS unsigned char* kimg = lds + st * 32768 + mp * 8192; const LAS unsigned char* vimg = lds + st * 32768 + 16384;
            qkt_half(p0, kimg, qr, r32, hi, -M0, 0); qkt_half(p1, kimg, qr, r32, hi, -M0, 1);
            const float dq = (float)(qrow - 64 * t - 4 * hi);
            float sum0 = 0.f, sum1 = 0.f;
#pragma unroll
            for (int r = 0; r < 16; ++r) { const float kk = (float)((r & 3) + 8 * (r >> 2)); p0[r] = __builtin_amdgcn_exp2f(p0[r] - slope2 * fabsf(dq - kk)); sum0 += p0[r]; }
            pv_half<4>(o, vimg, vl, p0, 0);
#pragma unroll
            for (int r = 0; r < 16; ++r) { const float kk = (float)((r & 3) + 8 * (r >> 2)); p1[r] = __builtin_amdgcn_exp2f(p1[r] - slope2 * fabsf(dq - kk - 32.0f)); sum1 += p1[r]; }
            pv_half<4>(o, vimg, vl, p1, 1);
            l_run += sum0 + sum1;
        }
        if (t + 1 < nT) WRITE_T(st ^ 1);
        __syncthreads();
    }
    const float lt = l_run + __shfl_xor(l_run, 32), inv = __builtin_amdgcn_rcpf(lt);
    LAS float* X = (LAS float*)lds;
    const int xr = g4 * 32 + r32;
    if (mp == 1) { const float f = inv * lam;
#pragma unroll
        for (int bk = 0; bk < 4; ++bk)
#pragma unroll
            for (int r = 0; r < 16; ++r) X[(bk * 32 + (r & 3) + 8 * (r >> 2) + 4 * hi) * 128 + xr] = o[bk][r] * f; }
    __syncthreads();
    if (mp == 0) { float sq = 0.f;
#pragma unroll
        for (int bk = 0; bk < 4; ++bk)
#pragma unroll
            for (int r = 0; r < 16; ++r) { const float v = o[bk][r] * inv - X[(bk * 32 + (r & 3) + 8 * (r >> 2) + 4 * hi) * 128 + xr]; o[bk][r] = v; sq += v * v; }
        sq += __shfl_xor(sq, 32);
        const float rs = __builtin_amdgcn_rsqf(sq * (1.0f / 128.0f) + 1e-6f);
#pragma unroll
        for (int bk = 0; bk < 4; ++bk)
#pragma unroll
            for (int i = 0; i < 4; ++i) { const f32x4 gv = *(const LAS f32x4*)(prm + 160 + bk * 32 + 8 * i + 4 * hi);
#pragma unroll
                for (int j = 0; j < 4; ++j) o[bk][4 * i + j] *= rs * gv[j]; }
        store_o<4>(A.obase + 1 * BUF + (rowbase + qrow) * PITCH + h * 128, o, hi); }
    __syncthreads();
#undef LOAD_T
#undef WRITE_T
}

__device__ __forceinline__ void attn_phase(const AttnArgs& A, GAS unsigned* counters, LAS unsigned char* lds) {
    LAS unsigned* bc = (LAS unsigned*)(lds + BC_OFF);
    if (threadIdx.x < 64) {
        LAS float* prm = (LAS float*)(lds + PRM_OFF); const int ln = threadIdx.x;
        const GAS float* lq = A.lambda_qk; const float s1 = wave_sum(lq[ln] * lq[64 + ln]), s2 = wave_sum(lq[128 + ln] * lq[192 + ln]);
        const float gb = A.qk_g_diff[ln] * A.qk_g_diff[64 + ln], gc = A.qk_g_ch[ln] * A.qk_g_ch[64 + ln]; float gmb = fabsf(gb), gmc = fabsf(gc);
#pragma unroll
        for (int o_ = 1; o_ < 64; o_ <<= 1) { gmb = fmaxf(gmb, __shfl_xor(gmb, o_)); gmc = fmaxf(gmc, __shfl_xor(gmc, o_)); }
        prm[32 + ln] = gb; prm[96 + ln] = gc; prm[160 + ln] = A.subln_g[ln] * (1.0f - A.lam_init); prm[224 + ln] = A.subln_g[64 + ln] * (1.0f - A.lam_init);
        const float M0c = 8.0f * gmc * LOG2E * 1.02f;
        if (ln == 0) { prm[0] = __expf(s1) - __expf(s2) + A.lam_init; prm[1] = 8.0f * gmb * LOG2E * 1.02f; }
        for (int hc = 0; hc < 8; ++hc) { float bmx = -3.0e38f, bmn = 3.0e38f;
            for (int j = ln; j < 257; j += 64) { const float v = A.rel_bias[hc * 257 + j]; bmx = fmaxf(bmx, v); bmn = fminf(bmn, v); }
#pragma unroll
            for (int o_ = 1; o_ < 64; o_ <<= 1) { bmx = fmaxf(bmx, __shfl_xor(bmx, o_)); bmn = fminf(bmn, __shfl_xor(bmn, o_)); }
            if (ln == 0) { prm[2 + hc] = M0c + bmx * LOG2E; prm[10 + hc] = (2.0f * M0c + (bmx - bmn) * LOG2E < 100.0f) ? 1.0f : 0.0f; } }
    }
    __syncthreads();
    const int x0 = (int)(__builtin_amdgcn_s_getreg((3 << 11) | 20) & 7u);
#pragma unroll 1
    for (int qn = 0; qn < 8; ++qn) {
        const int x = (x0 + qn) & 7; GAS unsigned* counter = counters + 64 * x;
        for (;;) {
            if (threadIdx.x == 0) *bc = __hip_atomic_fetch_add(counter, 1u, __ATOMIC_RELAXED, __HIP_MEMORY_SCOPE_AGENT);
            __syncthreads();
            const int idx = (int)__builtin_amdgcn_readfirstlane(*bc);
            __syncthreads();
            if (idx >= 384) break;
            if (idx < 128) { const int bh = x + 8 * (idx >> 4); unit_b(A, bh >> 2, bh & 3, 15 - (idx & 15), lds); }
            else if (idx < 256) { const int jc = idx - 128; const int bh = x + 8 * (jc >> 3); const int hc = bh & 7;
                const float shift = ((const LAS float*)(lds + PRM_OFF))[2 + hc]; const bool fixc = __builtin_amdgcn_readfirstlane(__float_as_uint(((const LAS float*)(lds + PRM_OFF))[10 + hc])) != 0u;
                if (fixc) unit_ac<2, true>(A, bh >> 3, hc, 7 - (jc & 7), lds, shift);
                else unit_ac<2, false>(A, bh >> 3, hc, 7 - (jc & 7), lds, 0.f); }
            else { const int ja = idx - 256; const int pr = x + 8 * (ja >> 5); unit_a4(A, pr >> 1, pr & 1, 31 - (ja & 31), lds); }
        }
    }
    __builtin_amdgcn_s_setprio(0);
}
#undef LAS
#undef MFMA32
}
#define LAS __attribute__((address_space(3)))
typedef unsigned short bf16_t;
typedef unsigned v4u __attribute__((ext_vector_type(4)));
typedef float f32x4 __attribute__((ext_vector_type(4)));
constexpr int NWAVES = 8;
constexpr int MT = 32768, DM = 1024, NQKV = 4608, NGATE = 3072, NIN = 7680, DFF = 2816, DEPTH = 4;
constexpr size_t MiB = 1u << 20;
constexpr size_t WS_CTL = 0, CTL_BYTES = 65536;
constexpr size_t WS_ROWSS = 1 * MiB, WS_SS = 3 * MiB, WS_RS1 = 11 * MiB;
constexpr size_t WS_WIN = 12 * MiB, WS_WB = 27 * MiB, WS_WOUT = 30 * MiB, WS_WGU = 32 * MiB, WS_WDOWN = 43 * MiB;
constexpr size_t WS_XB = 50 * MiB, WS_QKV = 114 * MiB, WS_G2 = 402 * MiB, WS_MERGED = WS_QKV + 3 * 32 * MiB  , WS_ACT = WS_QKV, WS_END = 466 * MiB;
constexpr int LDS_BYTES = 147456;

__device__ __forceinline__ unsigned f2bf(float f) { unsigned u = __builtin_bit_cast(unsigned, f); return (u + 0x7fffu + ((u >> 16) & 1u)) >> 16; }
__device__ __forceinline__ unsigned pk2(float lo, float hi) { return f2bf(lo) | (f2bf(hi) << 16); }
#define LDS_WAIT() asm volatile("s_waitcnt lgkmcnt(0)" ::: "memory")

template <class RowMap> __device__ __forceinline__ void transpose_item(const GAS float* W, int K, int N, GAS bf16_t* WT, const GAS float* gain, LAS float* scr, int item, int lane, RowMap rm) {
    const int nblk = N / 32, kb = item / nblk, nb = item % nblk, k0 = 64 * kb, n0 = 32 * nb;
    const int kr = lane >> 3, nc = 4 * (lane & 7);
    f32x4 v[8]; float gv[8];
#pragma unroll
    for (int i = 0; i < 8; ++i) { v[i] = *(const GAS f32x4*)(W + (size_t)(k0 + kr + 8 * i) * N + n0 + nc); gv[i] = gain ? gain[k0 + kr + 8 * i] : 1.0f; }
#pragma unroll
    for (int i = 0; i < 8; ++i) { LAS float* d = scr + (kr + 8 * i) * 33 + nc; const f32x4 w = v[i] * gv[i]; d[0] = w[0]; d[1] = w[1]; d[2] = w[2]; d[3] = w[3]; }
    LDS_WAIT(); asm volatile("" ::: "memory");
    const int c = lane & 7;
#pragma unroll
    for (int j = 0; j < 4; ++j) { const int n = (lane >> 3) + 8 * j; const LAS float* s = scr + (8 * c) * 33 + n;
        v4u o; o.x = pk2(s[0 * 33], s[1 * 33]); o.y = pk2(s[2 * 33], s[3 * 33]); o.z = pk2(s[4 * 33], s[5 * 33]); o.w = pk2(s[6 * 33], s[7 * 33]);
        *(GAS v4u*)(WT + (size_t)rm(n0 + n) * K + k0 + 8 * c) = o; }
    LDS_WAIT(); asm volatile("" ::: "memory");
}
struct MapId { int off; __device__ int operator()(int n) const { return off + n; } };
struct MapIn { __device__ int operator()(int n) const { if (n >= 4608) return n; const int s = n >> 9; const int d = (int)((0x872651430ULL >> (4 * s)) & 15ULL); return d * 512 + (n & 511); } };
struct MapGU { __device__ int operator()(int n) const { const int up = n >= 2816 ? 1 : 0; const int c = n - up * 2816; return (c >> 2) * 8 + up * 4 + (c & 3); } };

__device__ __forceinline__ unsigned long long ldptr(volatile LAS unsigned long long* PT, int i) { asm volatile("" : "+v"(PT)); const unsigned long long v = PT[i]; const unsigned lo = __builtin_amdgcn_readfirstlane((unsigned)v), hi = __builtin_amdgcn_readfirstlane((unsigned)(v >> 32)); return ((unsigned long long)hi << 32) | lo; }
#define XB_TMO      128
#define XB_XCNT(j)  (256  + 64 * (j))
#define XB_XSUB(j)  (1280 + 64 * (j))
#define XB_XGEN(j)  (2304 + 64 * (j))
#define XB_TOP      3328
#define XB_TOPGEN   3392
#define XCD_BAR_WORDS 3456
#define XB_SPIN_CAP (1u << 18)

__device__ __forceinline__ unsigned xb_ld(GAS unsigned* p)              { return __hip_atomic_load(p, __ATOMIC_RELAXED, __HIP_MEMORY_SCOPE_AGENT); }
__device__ __forceinline__ unsigned xb_add(GAS unsigned* p, unsigned v) { return __hip_atomic_fetch_add(p, v, __ATOMIC_RELAXED, __HIP_MEMORY_SCOPE_AGENT); }
__device__ __forceinline__ unsigned xb_xcc_id() { return (unsigned)__builtin_amdgcn_s_getreg((3 << 11) | 20) & 0xFu; }
#define XB_SPIN(cond, bar) do { unsigned _sp = 0; while (cond) { __builtin_amdgcn_s_sleep(1); \
    if ((++_sp & 255u) == 0u) { if (xb_ld(&(bar)[XB_TMO])) break; if (_sp > XB_SPIN_CAP) { xb_add(&(bar)[XB_TMO], 1u); break; } } } } while (0)

struct XcdBarrier {
    GAS unsigned* bar; unsigned x;
    volatile LAS unsigned* st;
};

__device__ __forceinline__ XcdBarrier xcd_barrier_post(GAS unsigned* bar, volatile LAS unsigned* st) {
    XcdBarrier b; b.bar = bar; b.x = xb_xcc_id(); b.st = st;
    if (threadIdx.x == 0) (void)xb_add(&bar[XB_XCNT(b.x)], 1u);
    return b;
}
__device__ __forceinline__ void xcd_barrier_complete(GAS unsigned* bar, unsigned x, unsigned& nloc, unsigned& nx) {
    const unsigned G = gridDim.x * gridDim.y * gridDim.z;
    unsigned sum, cnt, mine, sp = 0u;
    for (;;) {
        sum = 0u; cnt = 0u; mine = 0u;
#pragma unroll
        for (unsigned j = 0; j < 16; ++j) { const unsigned c = xb_ld(&bar[XB_XCNT(j)]); sum += c; cnt += (c > 0u) ? 1u : 0u; mine = (j == x) ? c : mine; }
        if (sum == G) break;
        __builtin_amdgcn_s_sleep(1);
        if ((++sp & 255u) == 0u) { if (xb_ld(&bar[XB_TMO])) break; if (sp > XB_SPIN_CAP) { xb_add(&bar[XB_TMO], 1u); break; } }
    }
    nloc = mine > 0u ? mine : 1u; nx = cnt > 0u ? cnt : 1u;
}

__device__ __forceinline__ void xcd_barrier(const XcdBarrier& b) {
    asm volatile("s_waitcnt vmcnt(0)" ::: "memory");
    __syncthreads();
    if (threadIdx.x == 0) {
        GAS unsigned* bar = b.bar;
        __builtin_amdgcn_s_waitcnt(0);
        unsigned nloc = b.st[0], nx = b.st[1];
        if (nloc == 0u) { xcd_barrier_complete(bar, b.x, nloc, nx); b.st[0] = nloc; b.st[1] = nx; }
        const unsigned old = xb_add(&bar[XB_XSUB(b.x)], 1u);
        const unsigned gen = old / nloc;
        if (old + 1u == (gen + 1u) * nloc) {
            __builtin_amdgcn_fence(__ATOMIC_RELEASE, "agent");
            asm volatile("s_waitcnt vmcnt(0)" ::: "memory");
            const unsigned og = xb_add(&bar[XB_TOP], 1u);
            const unsigned tg = og / nx;
            if (og + 1u == (tg + 1u) * nx) xb_add(&bar[XB_TOPGEN], 1u);
            else XB_SPIN(xb_ld(&bar[XB_TOPGEN]) == tg, bar);
            __builtin_amdgcn_fence(__ATOMIC_ACQUIRE, "agent");
            xb_add(&bar[XB_XGEN(b.x)], 1u);
            asm volatile("s_waitcnt vmcnt(0)" ::: "memory");
        } else {
            XB_SPIN(xb_ld(&bar[XB_XGEN(b.x)]) == gen, bar);
            __builtin_amdgcn_fence(__ATOMIC_ACQUIRE, "agent");
            asm volatile("s_waitcnt vmcnt(0)" ::: "memory");
        }
    }
    __syncthreads();
}
struct Args { const GAS float* in[16]; GAS float* out; unsigned char* ws; int ph_lo, ph_hi; };

__global__ void __launch_bounds__(NWAVES * 64, 2) fwd_kernel(Args args) {
    extern __shared__ __attribute__((aligned(16))) unsigned char lds_raw[];
    LAS unsigned char* lds = (LAS unsigned char*)lds_raw;
    cg::grid_group grid = cg::this_grid();
    const int tid = threadIdx.x;
    volatile LAS unsigned long long* PT = (volatile LAS unsigned long long*)(lds + 131072 + 2048);
    { unsigned long long v = (unsigned long long)args.ws;
#pragma unroll
      for (int i = 0; i < 16; ++i) v = (tid == i) ? (unsigned long long)args.in[i] : v;
      v = (tid == 16) ? (unsigned long long)args.out : v;
      if (tid < 18) PT[tid] = v; }
    volatile LAS unsigned* MISC = (volatile LAS unsigned*)(lds + 131072 + 1024);
    if (tid < 2) MISC[tid] = 0u;
    (void)xcd_barrier_post((GAS unsigned*)args.ws + 1024, MISC);
    __syncthreads();
#define PTRF(i) ((const GAS float*)ldptr(PT, (i)))
#define WSP(off) ((GAS unsigned char*)ldptr(PT, 17) + (off))
#define OUTP ((GAS float*)ldptr(PT, 16))
    const int lo = args.ph_lo, hi_ph = args.ph_hi;
#ifndef PHMASK
#define PHMASK 255
#endif
#define REP_G1 1
#define REP_GG 1
#define REP_G2 1
#define REP_G4 1
#define REP_G3 1
#define REP_G5 1
#ifndef REP_ATT
#define REP_ATT 1
#endif
#ifndef REP_P0
#define REP_P0 1
#endif
#ifndef EXTRA_SYNC
#define EXTRA_SYNC 0
#endif
#define IN(k) (((PHMASK >> ((k) & 7)) & 1) && lo <= (k) && (k) < hi_ph)
#define SEAM(k) do { if (IN(k) && IN((k) + 1)) { if ((k) == 0) grid.sync(); else { XcdBarrier xb_; xb_.bar = (GAS unsigned*)WSP(WS_CTL) + 1024; xb_.x = xb_xcc_id(); xb_.st = MISC; xcd_barrier(xb_); } } } while (0)
#pragma unroll 1
    for (int l = 0; l < DEPTH; ++l) {
        const int P = l * 8;
        if (IN(P + 0))
_Pragma("unroll 1")
        for (int rep_ = 0; rep_ < REP_P0; ++rep_) {
            int bid = blockIdx.x, Gl = gridDim.x; asm volatile("" : "+s"(bid), "+s"(Gl));
            int tl = threadIdx.x; asm volatile("" : "+v"(tl)); const int lane = tl & 63, wave = __builtin_amdgcn_readfirstlane(tl >> 6);
            LAS float* scr = (LAS float*)(lds + wave * 16384); const int gw = bid * NWAVES + wave, NGW = Gl * NWAVES;
            const GAS float* w_in = PTRF(2) + (size_t)l * DM * NIN; const GAS float* g_mix = PTRF(1) + (size_t)l * DM;
            const GAS float* w_sb = PTRF(9) + (size_t)l * 512 * DM; const GAS float* w_df = PTRF(10) + (size_t)l * 512 * DM; const GAS float* w_ch = PTRF(11) + (size_t)l * 512 * DM;
            const GAS float* w_out = PTRF(12) + (size_t)l * DM * DM; const GAS float* g_ffn = PTRF(13) + (size_t)l * DM;
            const GAS float* w_gu = PTRF(14) + (size_t)l * DM * 2 * DFF; const GAS float* w_down = PTRF(15) + (size_t)l * DFF * DM;
            constexpr int I_IN = (DM / 64) * (NIN / 32), I_B = (512 / 64) * (DM / 32), I_O = (DM / 64) * (DM / 32), I_GU = (DM / 64) * (2 * DFF / 32), I_DN = (DFF / 64) * (DM / 32);
            constexpr int NITEMS = I_IN + 3 * I_B + I_O + I_GU + I_DN;
            for (int it = gw; it < NITEMS; it += NGW) {
                int r = it;
                if (r < I_IN) { transpose_item(w_in, DM, NIN, ((GAS bf16_t*)WSP(WS_WIN)), g_mix, scr, r, lane, MapIn{}); continue; } r -= I_IN;
                if (r < I_B) { transpose_item(w_sb, 512, DM, ((GAS bf16_t*)WSP(WS_WB)), nullptr, scr, r, lane, MapId{0}); continue; } r -= I_B;
                if (r < I_B) { transpose_item(w_df, 512, DM, ((GAS bf16_t*)WSP(WS_WB)), nullptr, scr, r, lane, MapId{1024}); continue; } r -= I_B;
                if (r < I_B) { transpose_item(w_ch, 512, DM, ((GAS bf16_t*)WSP(WS_WB)), nullptr, scr, r, lane, MapId{2048}); continue; } r -= I_B;
                if (r < I_O) { transpose_item(w_out, DM, DM, ((GAS bf16_t*)WSP(WS_WOUT)), nullptr, scr, r, lane, MapId{0}); continue; } r -= I_O;
                if (r < I_GU) { transpose_item(w_gu, DM, 2 * DFF, ((GAS bf16_t*)WSP(WS_WGU)), g_ffn, scr, r, lane, MapGU{}); continue; } r -= I_GU;
                transpose_item(w_down, DFF, DM, ((GAS bf16_t*)WSP(WS_WDOWN)), nullptr, scr, r, lane, MapId{0});
            }
            if (l == 0) {
                for (int m = gw; m < MT; m += NGW) { const GAS f32x4* xr = (const GAS f32x4*)(PTRF(0) + (size_t)m * DM) + lane; f32x4 v[4]; float s = 0.f;
#pragma unroll
                    for (int j = 0; j < 4; ++j) { v[j] = xr[64 * j]; s += (v[j][0] * v[j][0] + v[j][1] * v[j][1]) + (v[j][2] * v[j][2] + v[j][3] * v[j][3]); }
                    s = att::wave_sum(s);
                    GAS unsigned long long* o8 = (GAS unsigned long long*)(((GAS bf16_t*)WSP(WS_XB)) + (size_t)m * DM) + lane;
#pragma unroll
                    for (int j = 0; j < 4; ++j) o8[64 * j] = (unsigned long long)pk2(v[j][0], v[j][1]) | ((unsigned long long)pk2(v[j][2], v[j][3]) << 32);
                    if (lane == 0) ((GAS float*)WSP(WS_RS1))[m] = __builtin_amdgcn_rsqf(s * (1.0f / 1024.0f) + 1e-6f); }
            } else {
                for (int m = gw * 64 + lane; m < MT; m += NGW * 64) ((GAS float*)WSP(WS_RS1))[m] = pg8::row_rs((const GAS float*)WSP(WS_ROWSS), m);
            }
        }
        SEAM(P + 0);
        for (int xs_ = 0; xs_ < EXTRA_SYNC; ++xs_) grid.sync();
        if (IN(P + 1))
_Pragma("unroll 1")
        for (int rep_ = 0; rep_ < REP_G1; ++rep_) {
            int bid = blockIdx.x, Gl = gridDim.x; asm volatile("" : "+s"(bid), "+s"(Gl));
            pg8::Gemm g{((GAS bf16_t*)WSP(WS_XB)), ((GAS bf16_t*)WSP(WS_WIN)), MT, NIN, DM}; pg8::StaticOrder S; S.init(MT, NIN, Gl, bid);
            pg8::EpiQKVG E{pg8::EpiQKV{((GAS bf16_t*)WSP(WS_QKV)), ((GAS float*)WSP(WS_ROWSS)), ((GAS float*)WSP(WS_SS)), ((const GAS float*)WSP(WS_RS1))}, (GAS bf16_t*)OUTP, (GAS bf16_t*)WSP(WS_G2), PTRF(3) + (size_t)l * NGATE};
            pg8::gemm_phase<pg8::EpiQKVG, pg8::StaticOrder, true, true>(lds, g, S, E);
        }
        SEAM(P + 1);
        if (IN(P + 2))
_Pragma("unroll 1")
        for (int rep_ = 0; rep_ < REP_ATT; ++rep_) {
            int bid = blockIdx.x, Gl = gridDim.x; asm volatile("" : "+s"(bid), "+s"(Gl));
            att::AttnArgs A{((GAS bf16_t*)WSP(WS_QKV)), ((GAS bf16_t*)WSP(rep_ + 1 < REP_ATT ? WS_MERGED : WS_QKV)), ((GAS float*)WSP(WS_SS)), PTRF(4) + (size_t)l * 128, PTRF(5) + (size_t)l * 256, PTRF(6) + (size_t)l * 128, PTRF(7) + (size_t)l * 128, PTRF(8) + (size_t)l * 8 * 257, 0.8f - 0.6f * __expf(-0.3f * (float)l)};
            att::attn_phase(A, ((GAS unsigned*)WSP(WS_CTL)) + 8192 + 512 * (l + 4 * rep_), lds);
            if (rep_ + 1 < REP_ATT) grid.sync();
        }
        SEAM(P + 2);
        if (IN(P + 4))
_Pragma("unroll 1")
        for (int rep_ = 0; rep_ < REP_G2; ++rep_) {
            int bid = blockIdx.x, Gl = gridDim.x; asm volatile("" : "+s"(bid), "+s"(Gl));
            pg8::Gemm g{((GAS bf16_t*)WSP(WS_QKV)), ((GAS bf16_t*)WSP(WS_WB)), 3 * MT, 3 * DM, 512}; const int vcu = (Gl % 8 == 0) ? (bid % 8) * (Gl / 8) + bid / 8 : bid; pg8::BranchOrder S{Gl, vcu};
            pg8::EpiBranch E{(const GAS bf16_t*)OUTP, (const GAS bf16_t*)WSP(WS_G2), ((GAS bf16_t*)WSP(WS_MERGED))};
            pg8::gemm_phase<pg8::EpiBranch, pg8::BranchOrder, true, true>(lds, g, S, E);
        }
        SEAM(P + 4);
        if (IN(P + 5))
_Pragma("unroll 1")
        for (int rep_ = 0; rep_ < REP_G3; ++rep_) {
            int bid = blockIdx.x, Gl = gridDim.x; asm volatile("" : "+s"(bid), "+s"(Gl));
            pg8::Gemm g{((GAS bf16_t*)WSP(WS_MERGED)), ((GAS bf16_t*)WSP(WS_WOUT)), MT, DM, DM}; pg8::StaticOrder S; S.init(MT, DM, Gl, bid);
            pg8::EpiResid E{(GAS float*)nullptr, ((GAS bf16_t*)WSP(WS_XB)), ((GAS float*)WSP(WS_ROWSS))};
            pg8::gemm_phase<pg8::EpiResid, pg8::StaticOrder, true, true>(lds, g, S, E);
        }
        SEAM(P + 5);
        if (IN(P + 6))
_Pragma("unroll 1")
        for (int rep_ = 0; rep_ < REP_G4; ++rep_) {
            int bid = blockIdx.x, Gl = gridDim.x; asm volatile("" : "+s"(bid), "+s"(Gl));
            pg8::Gemm g{((GAS bf16_t*)WSP(WS_XB)), ((GAS bf16_t*)WSP(WS_WGU)), MT, 2 * DFF, DM}; pg8::StaticOrder S; S.init(MT, 2 * DFF, Gl, bid);
            pg8::EpiSwiGLU E{((GAS bf16_t*)WSP(WS_ACT)), ((GAS float*)WSP(WS_ROWSS))};
            pg8::gemm_phase<pg8::EpiSwiGLU, pg8::StaticOrder, true, true>(lds, g, S, E);
        }
        SEAM(P + 6);
        if (IN(P + 7))
_Pragma("unroll 1")
        for (int rep_ = 0; rep_ < REP_G5; ++rep_) {
            int bid = blockIdx.x, Gl = gridDim.x; asm volatile("" : "+s"(bid), "+s"(Gl));
            pg8::Gemm g{((GAS bf16_t*)WSP(WS_ACT)), ((GAS bf16_t*)WSP(WS_WDOWN)), MT, DM, DFF}; pg8::StaticOrder S; S.init(MT, DM, Gl, bid);
            pg8::EpiResid E{(l == DEPTH - 1) ? OUTP : (GAS float*)nullptr, ((GAS bf16_t*)WSP(WS_XB)), ((GAS float*)WSP(WS_ROWSS))};
            pg8::gemm_phase<pg8::EpiResid, pg8::StaticOrder, true, true>(lds, g, S, E);
        }
        SEAM(P + 7);
    }
#undef IN
#undef SEAM
}

#ifndef MK_SPLIT
#define MK_SPLIT 0
#endif
extern "C" void kernel_launch(void* const* d_in, const int* in_sizes, int n_in, void* d_out, int out_size, void* d_ws, size_t ws_size, hipStream_t stream) {
    static int grid = 0;
    if (grid == 0) {
        if (n_in != 16 || in_sizes[0] != MT * DM || out_size != MT * DM || ws_size < WS_END) { fprintf(stderr, "kernel_launch: unexpected shapes / workspace (n_in %d, ws %zu); nothing launched\n", n_in, ws_size); grid = -1; return; }
        int dev = 0, cus = 0, per_cu = 0;
        if (hipGetDevice(&dev) != hipSuccess || hipDeviceGetAttribute(&cus, hipDeviceAttributeMultiprocessorCount, dev) != hipSuccess) { grid = -1; return; }
        if (hipFuncSetAttribute((const void*)fwd_kernel, hipFuncAttributeMaxDynamicSharedMemorySize, LDS_BYTES) != hipSuccess) { fprintf(stderr, "kernel_launch: hipFuncSetAttribute failed\n"); grid = -1; return; }
        if (hipOccupancyMaxActiveBlocksPerMultiprocessor(&per_cu, (const void*)fwd_kernel, NWAVES * 64, LDS_BYTES) != hipSuccess || per_cu < 1) { fprintf(stderr, "kernel_launch: occupancy query says %d blocks per CU\n", per_cu); per_cu = 1; }
        (void)hipGetLastError();
        grid = cus;
    }
    if (grid < 0) return;
    (void)hipMemsetAsync((char*)d_ws + WS_CTL, 0, CTL_BYTES, stream);
    Args a{};
    for (int i = 0; i < 16; ++i) a.in[i] = (const GAS float*)d_in[i];
    a.out = (GAS float*)d_out; a.ws = (unsigned char*)d_ws;
#if MK_SPLIT
    for (int p = 0; p < 8 * DEPTH; ++p) { a.ph_lo = p; a.ph_hi = p + 1; hipLaunchKernelGGL(fwd_kernel, dim3(grid), dim3(NWAVES * 64), LDS_BYTES, stream, a); }
#else
    a.ph_lo = 0; a.ph_hi = 8 * DEPTH;
    void* kargs[] = {&a};
    hipError_t e = hipLaunchCooperativeKernel((const void*)fwd_kernel, dim3(grid), dim3(NWAVES * 64), kargs, LDS_BYTES, stream);
    if (e != hipSuccess) fprintf(stderr, "kernel_launch: cooperative launch failed: %s (grid %d)\n", hipGetErrorString(e), grid);
#endif
}
```
